# Optimizing an MI355X kernel written in HIP

```python
import math
import jax, jax.numpy as jnp
from jax import lax
import numpy as np

D_MODEL = 1024
BATCH = 16
SEQ = 2048
DEPTH = 4

RET_HEADS = 4
RET_QK_DIM = 128
RET_V_DIM = 256
RET_QK_W = RET_HEADS * RET_QK_DIM
RET_V_W = RET_HEADS * RET_V_DIM
RET_CHUNK = 128
ROPE_BASE = 10000.0
POOL_WINDOWS = (2, 4, 8, 16)
POOL_GROUPS = 4
POOL_GROUP_DIM = D_MODEL // 8
POOL_W = POOL_GROUPS * POOL_GROUP_DIM
N_BRANCH = 2
IN_W = 2 * RET_QK_W + 2 * RET_V_W + POOL_W + N_BRANCH * D_MODEL
IN_SPLITS = (RET_QK_W, 2 * RET_QK_W, 2 * RET_QK_W + RET_V_W, 2 * RET_QK_W + 2 * RET_V_W,
             2 * RET_QK_W + 2 * RET_V_W + POOL_W, 2 * RET_QK_W + 2 * RET_V_W + POOL_W + D_MODEL)
N_EXPERTS = 16
N_GROUPS = 4
EXPERTS_PER_GROUP = N_EXPERTS // N_GROUPS
TOP_K = 2
D_EXPERT = D_MODEL // 2
MOE_BLOCK = 256
EPS = 1e-6

kernel_name = "hybrid_retention_pool_grouped_moe_adaln"


def rmsnorm(x, g):
    xf = x.astype(jnp.float32)
    y = xf * lax.rsqrt(jnp.mean(xf * xf, axis=-1, keepdims=True) + EPS)
    return y.astype(x.dtype) * g


def modulate(h, shift, scale):
    return h * (1.0 + scale[:, None, :]) + shift[:, None, :]


def rotary(t, pos):
    d = t.shape[-1]
    freqs = ROPE_BASE ** (-jnp.arange(0, d, 2, dtype=jnp.float32) / d)
    ang = pos[:, None] * freqs[None, :]
    cos = jnp.cos(ang).astype(t.dtype)
    sin = jnp.sin(ang).astype(t.dtype)
    t1, t2 = t[..., : d // 2], t[..., d // 2:]
    return jnp.concatenate([t1 * cos - t2 * sin, t1 * sin + t2 * cos], axis=-1)


def retention_chunkwise(q, k, v):
    b, h, s, dk = q.shape
    dv = v.shape[-1]
    c = RET_CHUNK
    n = s // c
    dt = q.dtype
    log_gamma = jnp.log(1.0 - 2.0 ** (-5.0 - jnp.arange(h, dtype=jnp.float32)))
    idx = jnp.arange(c, dtype=jnp.float32)
    rel = idx[:, None] - idx[None, :]
    causal = rel >= 0
    decay_in = jnp.where(causal[None], jnp.exp(log_gamma[:, None, None] * jnp.where(causal, rel, 0.0)[None]), 0.0)
    xi = jnp.exp(log_gamma[:, None] * (idx[None, :] + 1.0))
    zeta = jnp.exp(log_gamma[:, None] * (c - 1.0 - idx[None, :]))
    gamma_c = jnp.exp(log_gamma * c).astype(dt)
    qc = q.reshape(b, h, n, c, dk)
    kc = k.reshape(b, h, n, c, dk)
    vc = v.reshape(b, h, n, c, dv)
    scores = jnp.einsum('bhncd,bhnmd->bhncm', qc, kc) * decay_in[None, :, None].astype(dt)
    y_inner = jnp.einsum('bhncm,bhnme->bhnce', scores, vc)
    kv = jnp.einsum('bhnmd,bhnme->nbhde', kc * zeta[None, :, None, :, None].astype(dt), vc)

    def step(state, kv_n):
        return state * gamma_c[None, :, None, None] + kv_n, state

    _, prev = lax.scan(step, jnp.zeros((b, h, dk, dv), dt), kv)
    y_cross = jnp.einsum('bhncd,nbhde->bhnce', qc * xi[None, :, None, :, None].astype(dt), prev)
    return (y_inner + y_cross).reshape(b, h, s, dv)


def head_norm(y):
    yf = y.astype(jnp.float32)
    return (yf * lax.rsqrt(jnp.mean(yf * yf, axis=-1, keepdims=True) + EPS)).astype(y.dtype)


def multiscale_pool(u, pool_w, pool_scale):
    b, s, _ = u.shape
    ug = u.reshape(b, s, POOL_GROUPS, POOL_GROUP_DIM)
    cs = jnp.cumsum(ug.astype(jnp.float32), axis=1)
    cs = jnp.pad(cs, ((0, 0), (1, 0), (0, 0), (0, 0)))
    t = jnp.arange(s)
    win = jnp.array(POOL_WINDOWS, dtype=jnp.int32)
    lo = jnp.maximum(t[:, None] + 1 - win[None, :], 0)
    gidx = jnp.arange(POOL_GROUPS)[None, :]
    window_sum = cs[:, 1:] - cs[:, lo, gidx]
    count = jnp.minimum(t[:, None] + 1, win[None, :]).astype(jnp.float32)
    mix = (window_sum / count[None, :, :, None] - ug.astype(jnp.float32)).astype(u.dtype)
    y = jnp.einsum('bsgc,gcd->bsgd', mix, pool_w).reshape(b, s, POOL_W)
    return y * pool_scale


def mixer(h, w_in, w_ret_o, pool_w, pool_scale, w_pool_o, w_out):
    b, s, _ = h.shape
    proj = h @ w_in
    q, k, v, g, u, a_ret, a_pool = jnp.split(proj, IN_SPLITS, axis=-1)

    def heads(t, d):
        return t.reshape(b, s, RET_HEADS, d).transpose(0, 2, 1, 3)

    pos = jnp.arange(s, dtype=jnp.float32)
    qh = rotary(heads(q, RET_QK_DIM), pos)
    kh = rotary(heads(k, RET_QK_DIM), pos) * (RET_QK_DIM ** -0.5)
    y = retention_chunkwise(qh, kh, heads(v, RET_V_DIM))
    y = head_norm(y).transpose(0, 2, 1, 3).reshape(b, s, RET_V_W)
    y_ret = (jax.nn.silu(g) * y) @ w_ret_o
    y_pool = multiscale_pool(u, pool_w, pool_scale) @ w_pool_o
    merged = jax.nn.sigmoid(a_ret) * y_ret + jax.nn.sigmoid(a_pool) * y_pool
    return merged @ w_out


def route(hf, w_router, b_router):
    t = hf.shape[0]
    logits = (hf @ w_router).astype(jnp.float32) + b_router.astype(jnp.float32)
    probs = jax.nn.softmax(logits, axis=-1)
    grouped = probs.reshape(t, N_GROUPS, EXPERTS_PER_GROUP)
    group_score = lax.top_k(grouped, TOP_K)[0].sum(-1)
    sel_group = jnp.argmax(group_score, axis=-1)
    in_group = jnp.take_along_axis(grouped, sel_group[:, None, None], axis=1)[:, 0]
    top_p, top_local = lax.top_k(in_group, TOP_K)
    expert_idx = sel_group[:, None] * EXPERTS_PER_GROUP + top_local
    weights = top_p / jnp.sum(top_p, axis=-1, keepdims=True)
    return expert_idx, weights


def moe(h, w_router, b_router, w_gate, w_up, w_down):
    b, s, d = h.shape
    t = b * s
    hf = h.reshape(t, d)
    expert_idx, weights = route(hf, w_router, b_router)
    a = t * TOP_K
    e_flat = expert_idx.reshape(a)
    tok_flat = jnp.arange(a, dtype=jnp.int32) // TOP_K
    w_flat = weights.reshape(a)
    order = jnp.argsort(e_flat)
    e_sorted = e_flat[order]
    counts = jnp.bincount(e_flat, length=N_EXPERTS)
    padded = ((counts + MOE_BLOCK - 1) // MOE_BLOCK) * MOE_BLOCK
    start = jnp.cumsum(counts) - counts
    pad_end = jnp.cumsum(padded)
    pad_start = pad_end - padded
    dest = pad_start[e_sorted] + (jnp.arange(a) - start[e_sorted])
    n_slots = a + N_EXPERTS * MOE_BLOCK
    n_blocks = n_slots // MOE_BLOCK
    slot_tok = jnp.zeros((n_slots,), jnp.int32).at[dest].set(tok_flat[order])
    slot_w = jnp.zeros((n_slots,), jnp.float32).at[dest].set(w_flat[order])
    block_e = jnp.minimum(jnp.searchsorted(pad_end, jnp.arange(n_blocks) * MOE_BLOCK, side='right'), N_EXPERTS - 1)
    xb = hf[slot_tok].reshape(n_blocks, MOE_BLOCK, d)

    def expert_block(args):
        xblk, e = args
        return (jax.nn.silu(xblk @ w_gate[e]) * (xblk @ w_up[e])) @ w_down[e]

    yb = lax.map(expert_block, (xb, block_e))
    y_slots = yb.reshape(n_slots, d) * slot_w[:, None].astype(yb.dtype)
    return jax.ops.segment_sum(y_slots, slot_tok, num_segments=t).reshape(b, s, d)


def setup_inputs(seed: int = 0) -> dict:
    key = jax.random.key(seed)
    ks = jax.random.split(key, 20)
    f32 = jnp.float32
    nrm = lambda k, shape, sc: jax.random.normal(k, shape, f32) * sc
    return {
        "x": nrm(ks[0], (BATCH, SEQ, D_MODEL), 1.0),
        "c": nrm(ks[1], (BATCH, D_MODEL), 1.0),
        "w_ada": nrm(ks[2], (DEPTH, D_MODEL, 6 * D_MODEL), 0.5 * D_MODEL ** -0.5),
        "b_ada": nrm(ks[3], (DEPTH, 6 * D_MODEL), 0.02),
        "norm1_g": 1.0 + nrm(ks[4], (DEPTH, D_MODEL), 0.02),
        "norm2_g": 1.0 + nrm(ks[5], (DEPTH, D_MODEL), 0.02),
        "w_in": nrm(ks[6], (DEPTH, D_MODEL, IN_W), D_MODEL ** -0.5),
        "w_ret_o": nrm(ks[7], (DEPTH, RET_V_W, D_MODEL), RET_V_W ** -0.5),
        "pool_w": nrm(ks[8], (DEPTH, POOL_GROUPS, POOL_GROUP_DIM, POOL_GROUP_DIM), POOL_GROUP_DIM ** -0.5),
        "pool_scale": 1.0 + nrm(ks[9], (DEPTH, POOL_W), 0.1),
        "w_pool_o": nrm(ks[10], (DEPTH, POOL_W, D_MODEL), POOL_W ** -0.5),
        "w_out": nrm(ks[11], (DEPTH, D_MODEL, D_MODEL), D_MODEL ** -0.5),
        "w_router": nrm(ks[12], (D_MODEL, N_EXPERTS), D_MODEL ** -0.5),
        "b_router": nrm(ks[13], (N_EXPERTS,), 0.01),
        "w_e_gate": nrm(ks[14], (DEPTH, N_EXPERTS, D_MODEL, D_EXPERT), D_MODEL ** -0.5),
        "w_e_up": nrm(ks[15], (DEPTH, N_EXPERTS, D_MODEL, D_EXPERT), D_MODEL ** -0.5),
        "w_e_down": nrm(ks[16], (DEPTH, N_EXPERTS, D_EXPERT, D_MODEL), D_EXPERT ** -0.5),
        "final_g": 1.0 + nrm(ks[17], (D_MODEL,), 0.02),
    }


def reference(x, c, w_ada, b_ada, norm1_g, norm2_g, w_in, w_ret_o, pool_w, pool_scale, w_pool_o, w_out,
              w_router, b_router, w_e_gate, w_e_up, w_e_down, final_g):
    cond = jax.nn.silu(c)
    for l in range(DEPTH):
        mod = cond @ w_ada[l] + b_ada[l]
        sh1, sc1, g1, sh2, sc2, g2 = jnp.split(mod, 6, axis=-1)
        h = modulate(rmsnorm(x, norm1_g[l]), sh1, sc1)
        x = x + g1[:, None, :] * mixer(h, w_in[l], w_ret_o[l], pool_w[l], pool_scale[l], w_pool_o[l], w_out[l])
        h = modulate(rmsnorm(x, norm2_g[l]), sh2, sc2)
        x = x + g2[:, None, :] * moe(h, w_router, b_router, w_e_gate[l], w_e_up[l], w_e_down[l])
    return rmsnorm(x, final_g)
```

```cpp
#include <hip/hip_runtime.h>
#include <cstdio>
#include <cstdint>

#define LAS __attribute__((address_space(3)))
#ifndef REPMASK
#define REPMASK 0x000
#endif
#define NREP(j) (1 + ((REPMASK >> (j)) & 1))
typedef unsigned short bf16_t;
typedef short bf16x8 __attribute__((ext_vector_type(8)));
typedef float f32x4 __attribute__((ext_vector_type(4)));
typedef float f32x2 __attribute__((ext_vector_type(2)));
typedef unsigned u32x4 __attribute__((ext_vector_type(4)));
typedef unsigned u32x2 __attribute__((ext_vector_type(2)));

constexpr int NB = 16, SEQ = 2048, T = NB * SEQ, D = 1024, DEPTH = 4;
constexpr int INW = 5632, CQ = 0, CK = 512, CV = 1024, CG = 2048, CU = 3072, CAR = 3584, CAPL = 4608;
constexpr int NE = 16, DE = 512, CAP = 32768;
constexpr float EPS = 1e-6f;
constexpr int NWAVES = 8, NTHR = 512;

constexpr size_t MiB = 1u << 20;
constexpr size_t WS_CTL = 0, CTL_ZERO_BYTES = 65536;
constexpr size_t WS_MOD = 1 * MiB;
constexpr size_t WS_ROPE = 3 * MiB;
constexpr size_t WS_DEC = 2 * MiB + 512 * 1024;
constexpr size_t WS_STOK = 4 * MiB;
constexpr size_t WS_SW = 6 * MiB;
constexpr size_t WS_SSQ = 8 * MiB;
constexpr size_t WS_WL = 16 * MiB;
constexpr size_t WT_IN = WS_WL, WT_RO = WS_WL + 11 * MiB, WT_PE = WS_WL + 13 * MiB, WT_OUT = WS_WL + 14 * MiB, WT_GU = WS_WL + 16 * MiB, WT_DN = WS_WL + 48 * MiB;
constexpr size_t WS_H = 80 * MiB;
constexpr size_t WS_PROJ = 144 * MiB;
constexpr size_t WS_U = WS_PROJ;
constexpr size_t WS_M1 = WS_PROJ + 32 * MiB;
constexpr size_t WS_MRG = WS_PROJ + 96 * MiB;
constexpr size_t WS_ACT = WS_PROJ;
constexpr size_t WS_YBUF = WS_PROJ + 72 * MiB;
constexpr size_t WS_QB = 344 * MiB;
constexpr size_t WS_KB = 376 * MiB;
constexpr size_t WS_VB = 408 * MiB;
constexpr size_t WS_GB = 472 * MiB;
constexpr size_t WS_XB = 536 * MiB;
constexpr size_t WS_GATE = 600 * MiB;
constexpr size_t WS_SCR = WS_M1;
constexpr size_t WS_END = 664 * MiB;
constexpr int CW_CNT = 4096;

constexpr int LDS_BYTES = 163840;
constexpr int LDS_CNT = 131072 + 256;
constexpr int LDS_BARW = LDS_BYTES - 64;

__device__ __forceinline__ int rfl(int v) { return __builtin_amdgcn_readfirstlane(v); }
typedef __bf16 bf16x2_t __attribute__((ext_vector_type(2)));
__device__ __forceinline__ unsigned cvt_pk_bf16(float lo, float hi) { const f32x2 f = {lo, hi}; return __builtin_bit_cast(unsigned, __builtin_convertvector(f, bf16x2_t)); }
__device__ __forceinline__ bf16_t f2bf(float f) { return (bf16_t)(cvt_pk_bf16(f, 0.f) & 0xffffu); }
__device__ __forceinline__ float bf2f(bf16_t b) { return __uint_as_float(((unsigned)b) << 16); }
__device__ __forceinline__ float bflo(unsigned w) { return __uint_as_float(w << 16); }
__device__ __forceinline__ float bfhi(unsigned w) { return __uint_as_float(w & 0xffff0000u); }
__device__ __forceinline__ float wave_sum(float v) {
#pragma unroll
    for (int o = 1; o < 64; o <<= 1) v += __shfl_xor(v, o);
    return v;
}
__device__ __forceinline__ void unpack_u8x8(const u32x2 w, float (&o)[8]) {
    o[0] = (float)(w.x & 255u) * (1.0f / 255.0f); o[1] = (float)((w.x >> 8) & 255u) * (1.0f / 255.0f); o[2] = (float)((w.x >> 16) & 255u) * (1.0f / 255.0f); o[3] = (float)(w.x >> 24) * (1.0f / 255.0f);
    o[4] = (float)(w.y & 255u) * (1.0f / 255.0f); o[5] = (float)((w.y >> 8) & 255u) * (1.0f / 255.0f); o[6] = (float)((w.y >> 16) & 255u) * (1.0f / 255.0f); o[7] = (float)(w.y >> 24) * (1.0f / 255.0f);
}
__device__ __forceinline__ float sigmoid_f(float x) { return __builtin_amdgcn_rcpf(1.0f + __expf(-x)); }
__device__ __forceinline__ float silu_f(float x) { return x * sigmoid_f(x); }

#define XB_TMO      128
#define XB_XCNT(j)  (256  + 64 * (j))
#define XB_XSUB(j)  (1280 + 64 * (j))
#define XB_XGEN(j)  (2304 + 64 * (j))
#define XB_TOP      3328
#define XB_TOPGEN   3392
#define XCD_BAR_WORDS 3456
#define XB_SPIN_CAP (1u << 21)

__device__ __forceinline__ unsigned xb_ld(unsigned* p)              { return __hip_atomic_load(p, __ATOMIC_RELAXED, __HIP_MEMORY_SCOPE_AGENT); }
__device__ __forceinline__ unsigned xb_add(unsigned* p, unsigned v) { return __hip_atomic_fetch_add(p, v, __ATOMIC_RELAXED, __HIP_MEMORY_SCOPE_AGENT); }
__device__ __forceinline__ unsigned xb_xcc_id() { return (unsigned)__builtin_amdgcn_s_getreg((3 << 11) | 20) & 0xFu; }
#define XB_SPIN(cond, bar) do { unsigned _sp = 0; while (cond) { __builtin_amdgcn_s_sleep(1); \
    if ((++_sp & 255u) == 0u) { if (xb_ld(&(bar)[XB_TMO])) break; if (_sp > XB_SPIN_CAP) { atomicAdd(&(bar)[XB_TMO], 1u); break; } } } } while (0)

struct XcdBarrier { unsigned* bar; unsigned x; volatile LAS unsigned* st; };

__device__ __forceinline__ XcdBarrier xcd_barrier_post(unsigned* bar, volatile LAS unsigned* st) {
    XcdBarrier b; b.bar = bar; b.x = xb_xcc_id(); b.st = st;
    if (threadIdx.x == 0) (void)xb_add(&bar[XB_XCNT(b.x)], 1u);
    return b;
}
__device__ __forceinline__ void xcd_barrier_complete(unsigned* bar, unsigned x, unsigned& nloc, unsigned& nx) {
    const unsigned G = gridDim.x * gridDim.y * gridDim.z;
    unsigned sum, cnt, mine, sp = 0u;
    for (;;) {
        sum = 0u; cnt = 0u; mine = 0u;
#pragma unroll
        for (unsigned j = 0; j < 16; ++j) { const unsigned c = xb_ld(&bar[XB_XCNT(j)]); sum += c; cnt += (c > 0u) ? 1u : 0u; mine = (j == x) ? c : mine; }
        if (sum == G) break;
        __builtin_amdgcn_s_sleep(1);
        if ((++sp & 255u) == 0u) { if (xb_ld(&bar[XB_TMO])) break; if (sp > XB_SPIN_CAP) { atomicAdd(&bar[XB_TMO], 1u); break; } }
    }
    nloc = mine > 0u ? mine : 1u; nx = cnt > 0u ? cnt : 1u;
}
__device__ __forceinline__ void xcd_barrier(const XcdBarrier& b) {
    asm volatile("s_waitcnt vmcnt(0)" ::: "memory");
    __syncthreads();
    if (threadIdx.x == 0) {
        unsigned* bar = b.bar;
        __builtin_amdgcn_s_waitcnt(0);
        unsigned nloc = b.st[0], nx = b.st[1];
        if (nloc == 0u) { xcd_barrier_complete(bar, b.x, nloc, nx); b.st[0] = nloc; b.st[1] = nx; }
        const unsigned old = xb_add(&bar[XB_XSUB(b.x)], 1u);
        const unsigned gen = old / nloc;
        if (old + 1u == (gen + 1u) * nloc) {
            __builtin_amdgcn_fence(__ATOMIC_RELEASE, "agent");
            asm volatile("s_waitcnt vmcnt(0)" ::: "memory");
            const unsigned og = xb_add(&bar[XB_TOP], 1u);
            const unsigned tg = og / nx;
            if (og + 1u == (tg + 1u) * nx) xb_add(&bar[XB_TOPGEN], 1u);
            else XB_SPIN(xb_ld(&bar[XB_TOPGEN]) == tg, bar);
            __builtin_amdgcn_fence(__ATOMIC_ACQUIRE, "agent");
            xb_add(&bar[XB_XGEN(b.x)], 1u);
            asm volatile("s_waitcnt vmcnt(0)" ::: "memory");
        } else {
            XB_SPIN(xb_ld(&bar[XB_XGEN(b.x)]) == gen, bar);
            __builtin_amdgcn_fence(__ATOMIC_ACQUIRE, "agent");
            asm volatile("s_waitcnt vmcnt(0)" ::: "memory");
        }
    }
    __syncthreads();
}

__device__ __forceinline__ size_t gate_off(int pm, int gt, int ai, int m, int bj, int tid) { return ((size_t)((pm * 8 + gt) * 16 + (ai * 4 + m) * 2 + bj) * 512 + tid) * 8; }
__device__ __forceinline__ size_t m1_off(int pm, int pn, int ai, int m, int bj, int tid) { return ((size_t)((pm * 4 + pn) * 16 + (ai * 4 + m) * 2 + bj) * 512 + tid) * 16; }
namespace pg8 {
constexpr int BM = 256, BK = 64, HALF = 128, HTB = HALF * BK * 2, STAGE_BYTES = 8 * HTB, NXCD = 8, WGM = 8;
__host__ __device__ __forceinline__ int lds_byte(int r, int c) { const int st = (r >> 4) * 2 + (c >> 5), rr = r & 15, cc = c & 31, ob = rr * 64 + cc * 2; return st * 1024 + (ob ^ (((ob >> 9) & 1) << 5)); }
__host__ __device__ __forceinline__ void stage_rc(int b, int& R, int& C) { const int st = b / 1024, sb = b % 1024, swz = sb ^ (((sb >> 9) & 1) << 5); R = (st >> 1) * 16 + swz / 64; C = (st & 1) * 32 + (swz % 64) / 2; }
__host__ __device__ __forceinline__ int perm32(int rho) { const int n = rho >> 4, i = rho & 15; return 8 * (i >> 2) + 4 * n + (i & 3); }

struct DUnit { int pm, pn; };
struct DenseOrder {
    typedef DUnit Unit; static constexpr bool GATHER = false;
    int nM, nN, nwg, G, c; const char* A; const char* Bt; size_t atile, btile; int wgm = WGM;
    __device__ __forceinline__ void init(int M, int N, int G_, int c_, const bf16_t* A_, int lda, const bf16_t* Bt_, int K) {
        nM = M / BM; nN = N / BM; nwg = nM * nN; G = G_; c = c_; A = (const char*)A_; Bt = (const char*)Bt_; atile = (size_t)BM * lda * 2; btile = (size_t)BM * K * 2; }
    __device__ __forceinline__ bool next(int i, Unit& u) const {
        const long L = (long)i * G + c; if (L >= nwg) return false;
        int wgid = (int)L; { const int q = nwg / NXCD, r = nwg % NXCD, xcd = wgid % NXCD, off = wgid / NXCD; wgid = (xcd < r ? xcd * (q + 1) : r * (q + 1) + (xcd - r) * q) + off; }
        const int nig = wgm * nN, gid = wgid / nig, fm = gid * wgm, gsz = (nM - fm) < wgm ? (nM - fm) : wgm;
        u.pm = fm + ((wgid % nig) % gsz); u.pn = (wgid % nig) / gsz; return true;
    }
    __device__ __forceinline__ const char* a_ptr(const Unit& u) const { return A + (size_t)u.pm * atile; }
    __device__ __forceinline__ const char* b_ptr(const Unit& u) const { return Bt + (size_t)u.pn * btile; }
    __device__ __forceinline__ unsigned a_voff(const Unit&, int, int, int) const { return 0u; }
};
struct HUnit { int pm, pn, hh; };
struct HeadOrder {
    typedef HUnit Unit; static constexpr bool GATHER = false;
    DenseOrder d;
    __device__ __forceinline__ bool next(int i, Unit& u) const { DUnit t; if (!d.next(i >> 2, t)) return false; u.pm = t.pm; u.pn = t.pn; u.hh = i & 3; return true; }
    __device__ __forceinline__ const char* a_ptr(const Unit& u) const { return d.A + ((size_t)((((u.pm >> 3) * 4 + u.hh) * 4) * SEQ + (u.pm & 7) * BM)) * 128; }
    __device__ __forceinline__ const char* b_ptr(const Unit& u) const { return d.Bt + (size_t)u.pn * d.btile + u.hh * 512; }
    __device__ __forceinline__ unsigned a_voff(const Unit&, int, int, int) const { return 0u; }
};
struct RetOrder {
    typedef DUnit Unit; static constexpr bool GATHER = false;
    DenseOrder d;
    __device__ __forceinline__ bool next(int i, Unit& u) const { return d.next(i, u); }
    __device__ __forceinline__ const char* a_ptr(const Unit& u) const { return d.A + ((size_t)(((u.pm >> 3) * 16) * SEQ + (u.pm & 7) * BM)) * 128; }
    __device__ __forceinline__ const char* b_ptr(const Unit& u) const { return d.b_ptr(u); }
    __device__ __forceinline__ unsigned a_voff(const Unit&, int, int, int) const { return 0u; }
};
struct MUnit { int pm, pn, e, pos0, cnt; };
template <bool GATHER_>
struct MoeOrder {
    typedef MUnit Unit; static constexpr bool GATHER = GATHER_;
    const LAS int* cnts; int G, c; const char* A; const char* Bt; size_t atile, bexp, btile; const int* stok; int lda;
    __device__ __forceinline__ bool next(int i, Unit& u) const {
        const int L = i * G + c; const int mt = L >> 2;
        int acc = 0, fe = -1, fpos = 0, fcnt = 0;
#pragma unroll
        for (int e = 0; e < NE; ++e) { const int ce = cnts[e]; const int te = (ce + 255) >> 8; if (mt >= acc && mt < acc + te) { fe = e; fpos = (mt - acc) << 8; fcnt = ce; } acc += te; }
        fe = rfl(fe); if (fe < 0) return false;
        u.pm = mt; u.pn = L & 3; u.e = fe; u.pos0 = rfl(fpos); u.cnt = rfl(fcnt); return true;
    }
    __device__ __forceinline__ const char* a_ptr(const Unit& u) const { return GATHER ? A : A + (size_t)u.pm * atile; }
    __device__ __forceinline__ const char* b_ptr(const Unit& u) const { return Bt + (size_t)u.e * bexp + (size_t)u.pn * btile; }
    __device__ __forceinline__ unsigned a_voff(const Unit& u, int h, int R, int C) const {
        int pos = u.pos0 + h * HALF + R; pos = pos < u.cnt ? pos : u.cnt - 1;
        const int tok = stok[(size_t)u.e * CAP + pos] >> 1;
        return (unsigned)(tok * lda + C) * 2u;
    }
};

template <class E, class = void> struct has_khook { static constexpr bool v = false; };
template <class E> struct has_khook<E, decltype((void)E::KHOOK)> { static constexpr bool v = E::KHOOK; };
template <class Epi, class Sched>
__device__ __forceinline__ void gemm_phase(LAS unsigned char* lds, const Sched& S, const Epi& E, const int K, const int lda, const int ldb, const size_t kstepA = 128) {
    typedef typename Sched::Unit Unit;
    int tid = threadIdx.x; asm volatile("" : "+v"(tid));
    const int wid = rfl(tid >> 6), lane = tid & 63, wr = wid >> 2, wc = wid & 3, fr = lane & 15, fq = lane >> 4;
    const int nt = K / BK;
    int Rr[2], Cc[2]; unsigned voffB[2];
#pragma unroll
    for (int i = 0; i < 2; ++i) { int R, C; stage_rc(tid * 16 + i * 8192, R, C); Rr[i] = R; Cc[i] = C; const int Rb = Epi::PERM ? ((R & ~31) + perm32(R & 31)) : R; voffB[i] = (unsigned)(Rb * ldb + C) * 2u; }
    const size_t kstep = (size_t)(BK * 2);
    const size_t hstepB = (size_t)HALF * ldb * 2;
    const unsigned ldsw = (unsigned)wid * 1024u;
    const int aoff = lds_byte(wr * 64 + fr, fq * 8), boff = lds_byte(wc * 32 + fr, fq * 8);
#define PG8_SA(b, h) (((b) * 2 + (h)) * HTB)
#define PG8_SB(b, h) ((4 + (b) * 2 + (h)) * HTB)
#define PG8_STAGE(bufoff, gbase, voff) do { _Pragma("unroll") for (int _i = 0; _i < 2; ++_i) \
        __builtin_amdgcn_global_load_lds((const unsigned*)((const char*)(gbase) + (voff)[_i]), (LAS unsigned*)(lds + (bufoff) + ldsw + _i * 8192), 16, 0, 0); } while (0)
#define PG8_LDA(dst, b, h) do { _Pragma("unroll") for (int m = 0; m < 4; ++m) _Pragma("unroll") for (int k = 0; k < 2; ++k) dst[m][k] = *(const LAS bf16x8*)(lds + PG8_SA(b, h) + aoff + m * 2048 + k * 1024); } while (0)
#define PG8_LDB(dst, b, h) do { _Pragma("unroll") for (int n = 0; n < 2; ++n) _Pragma("unroll") for (int k = 0; k < 2; ++k) dst[n][k] = *(const LAS bf16x8*)(lds + PG8_SB(b, h) + boff + n * 2048 + k * 1024); } while (0)
#define PG8_MMA(ai, bj, At, Bt) do { __builtin_amdgcn_s_setprio(1); _Pragma("unroll") for (int m = 0; m < 4; ++m) _Pragma("unroll") for (int n = 0; n < 2; ++n) _Pragma("unroll") for (int k = 0; k < 2; ++k) \
        acc[ai][bj][m][n] = __builtin_amdgcn_mfma_f32_16x16x32_bf16(Bt[n][k], At[m][k], acc[ai][bj][m][n], 0, 0, 0); __builtin_amdgcn_s_setprio(0); } while (0)
#define PG8_WAIT_V(n) asm volatile("s_waitcnt vmcnt(" #n ")" ::: "memory")
#define PG8_WAIT_L(n) asm volatile("s_waitcnt lgkmcnt(" #n ")" ::: "memory")
#define PG8_BAR __builtin_amdgcn_s_barrier()
#define PG8_SCHED __builtin_amdgcn_sched_barrier(0)
    Unit cur, nxt; int ui = 0;
    if (!S.next(0, cur)) return;
    unsigned vAc[2][2], vAn[2][2];
#pragma unroll
    for (int h = 0; h < 2; ++h)
#pragma unroll
        for (int i = 0; i < 2; ++i) { vAc[h][i] = Sched::GATHER ? S.a_voff(cur, h, Rr[i], Cc[i]) : (unsigned)((h * HALF + Rr[i]) * lda + Cc[i]) * 2u; vAn[h][i] = vAc[h][i]; }
    f32x4 acc[2][2][4][2];
#pragma unroll
    for (int a = 0; a < 2; ++a)
#pragma unroll
        for (int b = 0; b < 2; ++b)
#pragma unroll
            for (int m = 0; m < 4; ++m)
#pragma unroll
                for (int n = 0; n < 2; ++n) acc[a][b][m][n] = (f32x4){0.f, 0.f, 0.f, 0.f};
    bf16x8 At[4][2], B0[2][2], B1[2][2];
    const char* cA = S.a_ptr(cur); const char* cB = S.b_ptr(cur);
    PG8_STAGE(PG8_SB(0, 0), cB, voffB); PG8_STAGE(PG8_SB(0, 1), cB + hstepB, voffB); PG8_STAGE(PG8_SA(0, 0), cA, vAc[0]); PG8_STAGE(PG8_SA(0, 1), cA, vAc[1]);
    if (wr == 1) PG8_BAR;
    PG8_WAIT_V(2); PG8_BAR;
    PG8_STAGE(PG8_SB(1, 0), cB + kstep, voffB); PG8_STAGE(PG8_SA(1, 0), cA + kstepA, vAc[0]); PG8_STAGE(PG8_SB(1, 1), cB + hstepB + kstep, voffB);
    PG8_WAIT_V(6); PG8_BAR;
    for (;;) {
        const bool has_next = S.next(ui + 1, nxt);
        const char* nA = has_next ? S.a_ptr(nxt) : cA; const char* nB = has_next ? S.b_ptr(nxt) : cB;
        if constexpr (Sched::GATHER) {
            if (has_next) {
#pragma unroll
                for (int h = 0; h < 2; ++h)
#pragma unroll
                    for (int i = 0; i < 2; ++i) vAn[h][i] = S.a_voff(nxt, h, Rr[i], Cc[i]);
            }
        }
        for (int t = 0; t < nt; t += 2) {
            const bool last = (t == nt - 2);
            if constexpr (has_khook<Epi>::v) { if (t != 0 && (t & 3) == 0) E.khook(acc, ui, t, wr, fr, lds); }
            size_t tk = (size_t)t * kstep; asm volatile("" : "+s"(tk));
            size_t tkA = (size_t)t * kstepA; asm volatile("" : "+s"(tkA));
            const char* a1 = cA + tkA + kstepA;
            const char* a2 = last ? nA : cA + tkA + 2 * kstepA; const char* b2 = last ? nB : cB + tk + 2 * kstep;
            const char* a3 = a2 + kstepA; const char* b3 = b2 + kstep;
            unsigned s0[2], s1[2];
#pragma unroll
            for (int i = 0; i < 2; ++i) { s0[i] = (Sched::GATHER && last) ? vAn[0][i] : vAc[0][i]; s1[i] = (Sched::GATHER && last) ? vAn[1][i] : vAc[1][i]; }
            PG8_LDB(B0, 0, 0); PG8_LDB(B1, 0, 1); PG8_SCHED; PG8_LDA(At, 0, 0); PG8_STAGE(PG8_SA(1, 1), a1, vAc[1]);
            PG8_WAIT_V(8); PG8_WAIT_L(0); PG8_BAR; PG8_MMA(0, 0, At, B0); PG8_MMA(0, 1, At, B1); PG8_BAR; PG8_SCHED;
            PG8_LDA(At, 0, 1); PG8_STAGE(PG8_SB(0, 0), b2, voffB); PG8_STAGE(PG8_SB(0, 1), b2 + hstepB, voffB); PG8_STAGE(PG8_SA(0, 0), a2, s0);
            PG8_WAIT_V(8); PG8_WAIT_L(0); PG8_BAR; PG8_MMA(1, 0, At, B0); PG8_MMA(1, 1, At, B1); PG8_BAR; PG8_SCHED;
            PG8_LDB(B0, 1, 0); PG8_LDB(B1, 1, 1); PG8_SCHED; PG8_LDA(At, 1, 0); PG8_STAGE(PG8_SA(0, 1), a2, s1);
            PG8_WAIT_V(8); PG8_WAIT_L(0); PG8_BAR; PG8_MMA(0, 0, At, B0); PG8_MMA(0, 1, At, B1); PG8_BAR; PG8_SCHED;
            PG8_LDA(At, 1, 1); PG8_STAGE(PG8_SB(1, 0), b3, voffB); PG8_STAGE(PG8_SB(1, 1), b3 + hstepB, voffB); PG8_STAGE(PG8_SA(1, 0), a3, s0);
            PG8_WAIT_V(8); PG8_WAIT_L(0); PG8_BAR; PG8_MMA(1, 0, At, B0); PG8_MMA(1, 1, At, B1); PG8_BAR; PG8_SCHED;
        }
        if (wr == 0) PG8_BAR;
        bool keep = false;
        if constexpr (Epi::SUBUNITS) keep = E.sub(acc, cur, ui, wr, wc, fr, fq, lds); else if constexpr (has_khook<Epi>::v) E.fin(acc, cur, ui, wr, wc, fr, fq, lds); else E(acc, cur, wr, wc, fr, fq);
        if (!has_next) break;
        if (!keep) {
        float zz = 0.f; if constexpr (Epi::SUBUNITS) asm volatile("" : "+v"(zz));
#pragma unroll
        for (int a = 0; a < 2; ++a)
#pragma unroll
            for (int b = 0; b < 2; ++b)
#pragma unroll
                for (int m = 0; m < 4; ++m)
#pragma unroll
                    for (int n = 0; n < 2; ++n) acc[a][b][m][n] = (f32x4){zz, zz, zz, zz};
        }
        cur = nxt; cA = nA; cB = nB; ++ui;
        if constexpr (Sched::GATHER) {
#pragma unroll
            for (int h = 0; h < 2; ++h)
#pragma unroll
                for (int i = 0; i < 2; ++i) vAc[h][i] = vAn[h][i];
        }
        if (wr == 1) PG8_BAR;
    }
    PG8_WAIT_V(0);
    PG8_BAR;
#undef PG8_SA
#undef PG8_SB
#undef PG8_STAGE
#undef PG8_LDA
#undef PG8_LDB
#undef PG8_MMA
#undef PG8_WAIT_V
#undef PG8_WAIT_L
#undef PG8_BAR
#undef PG8_SCHED
}

struct EpiStore {
    static constexpr bool PERM = true, SUBUNITS = false;
    bf16_t* O; int ldc;
    __device__ __forceinline__ void operator()(const f32x4 (&acc)[2][2][4][2], const DUnit& u, int wr, int wc, int fr, int fq) const {
        const int row0 = u.pm * BM + wr * 64 + fr, col0 = u.pn * BM + wc * 32 + 8 * fq;
#pragma unroll
        for (int ai = 0; ai < 2; ++ai)
#pragma unroll
            for (int m = 0; m < 4; ++m) { bf16_t* rowp = O + (size_t)(row0 + ai * HALF + m * 16) * ldc + col0;
#pragma unroll
                for (int bj = 0; bj < 2; ++bj) { const f32x4 v0 = acc[ai][bj][m][0], v1 = acc[ai][bj][m][1];
                    u32x4 w; w.x = cvt_pk_bf16(v0[0], v0[1]); w.y = cvt_pk_bf16(v0[2], v0[3]); w.z = cvt_pk_bf16(v1[0], v1[1]); w.w = cvt_pk_bf16(v1[2], v1[3]);
                    *(u32x4*)(rowp + bj * HALF) = w; } }
    }
};
struct EpiProj {
    static constexpr bool PERM = true, SUBUNITS = false, PROBE2 = false;
    unsigned char* ws; const float* cosT; const float* sinT; const float* dec;
    __device__ __forceinline__ void operator()(const f32x4 (&acc)[2][2][4][2], const DUnit& u, int wr, int wc, int fr, int fq) const {
        const int b = u.pm >> 3, pos0 = (u.pm & 7) * BM + wr * 64 + fr;
        if (u.pn < 4) {
            const int i0 = 16 * wc + 4 * fq;
            const float* dtab = dec + (u.pn >> 1) * (4 * SEQ) + (2 * (u.pn & 1)) * SEQ;
            bf16_t* base = (bf16_t*)(ws + (u.pn < 2 ? WS_QB : WS_KB));
#pragma unroll
            for (int ai = 0; ai < 2; ++ai)
#pragma unroll
                for (int m = 0; m < 4; ++m) { const int pos = pos0 + ai * HALF + m * 16;
                    const f32x4 c4 = *(const f32x4*)(cosT + pos * 64 + i0), s4 = *(const f32x4*)(sinT + pos * 64 + i0);
#pragma unroll
                    for (int bj = 0; bj < 2; ++bj) { const f32x4 t1 = acc[ai][bj][m][0], t2 = acc[ai][bj][m][1]; const float dsc = dtab[bj * SEQ + pos];
                        const f32x4 o1 = (t1 * c4 - t2 * s4) * dsc, o2 = (t1 * s4 + t2 * c4) * dsc;
                        bf16_t* dst = base + ((size_t)((b * 4 + 2 * (u.pn & 1) + bj) * SEQ + pos)) * 128 + i0;
                        u32x2 w1, w2; w1.x = cvt_pk_bf16(o1[0], o1[1]); w1.y = cvt_pk_bf16(o1[2], o1[3]); w2.x = cvt_pk_bf16(o2[0], o2[1]); w2.y = cvt_pk_bf16(o2[2], o2[3]);
                        *(u32x2*)dst = w1; *(u32x2*)(dst + 64) = w2; } }
        } else if (u.pn < 12) {
            bf16_t* base = (bf16_t*)(ws + (u.pn < 8 ? WS_VB : WS_GB)); const int head = (u.pn - 4) & 3; const int e0 = 32 * (wc & 1) + 8 * fq;
#pragma unroll
            for (int ai = 0; ai < 2; ++ai)
#pragma unroll
                for (int m = 0; m < 4; ++m) { const int pos = pos0 + ai * HALF + m * 16;
#pragma unroll
                    for (int bj = 0; bj < 2; ++bj) { const f32x4 v0 = acc[ai][bj][m][0], v1 = acc[ai][bj][m][1];
                        u32x4 w; w.x = cvt_pk_bf16(v0[0], v0[1]); w.y = cvt_pk_bf16(v0[2], v0[3]); w.z = cvt_pk_bf16(v1[0], v1[1]); w.w = cvt_pk_bf16(v1[2], v1[3]);
                        *(u32x4*)(base + ((size_t)(((b * 4 + head) * 4 + 2 * bj + (wc >> 1)) * SEQ + pos)) * 64 + e0) = w; } }
        } else if (u.pn >= 14) {
            unsigned char* GA = ws + WS_GATE;
            const int col0 = (u.pn - 14) * BM + wc * 32 + 8 * fq;
#pragma unroll
            for (int ai = 0; ai < 2; ++ai)
#pragma unroll
                for (int m = 0; m < 4; ++m) {
#pragma unroll
                    for (int bj = 0; bj < 2; ++bj) { const f32x4 v0 = acc[ai][bj][m][0], v1 = acc[ai][bj][m][1];
                        unsigned q[8];
#pragma unroll
                        for (int k = 0; k < 4; ++k) { q[k] = (unsigned)(sigmoid_f(v0[k]) * 255.0f + 0.5f); q[4 + k] = (unsigned)(sigmoid_f(v1[k]) * 255.0f + 0.5f); }
                        u32x2 w; w.x = q[0] | (q[1] << 8) | (q[2] << 16) | (q[3] << 24); w.y = q[4] | (q[5] << 8) | (q[6] << 16) | (q[7] << 24);
                        *(u32x2*)(GA + gate_off(u.pm, u.pn - 14, ai, m, bj, wr * 256 + wc * 64 + fq * 16 + fr)) = w; } }
        } else {
            bf16_t* U = (bf16_t*)(ws + WS_U);
            const int col0 = (u.pn - 12) * BM + wc * 32 + 8 * fq;
#pragma unroll
            for (int ai = 0; ai < 2; ++ai)
#pragma unroll
                for (int m = 0; m < 4; ++m) { bf16_t* rowp = U + (size_t)(b * SEQ + pos0 + ai * HALF + m * 16) * 512 + col0;
#pragma unroll
                    for (int bj = 0; bj < 2; ++bj) { const f32x4 v0 = acc[ai][bj][m][0], v1 = acc[ai][bj][m][1];
                        u32x4 w; w.x = cvt_pk_bf16(v0[0], v0[1]); w.y = cvt_pk_bf16(v0[2], v0[3]); w.z = cvt_pk_bf16(v1[0], v1[1]); w.w = cvt_pk_bf16(v1[2], v1[3]);
                        *(u32x4*)(rowp + bj * HALF) = w; } }
        }
    }
};
constexpr int LDS_RTAB = 131072 + 512, RTAB_MAXU = 6;
struct EpiRet {
    static constexpr bool PERM = true, SUBUNITS = true;
    const float* ssq; const unsigned char* gate; bf16_t* O;
    __device__ __forceinline__ void fill_table(const DUnit& u, int ti, int tid, LAS unsigned char* lds) const {
        if (tid < 256) { const float* sp = ssq + (size_t)(u.pm * BM + tid) * 16; float rs[4];
#pragma unroll
            for (int h = 0; h < 4; ++h) { const f32x4 s4 = *(const f32x4*)(sp + 4 * h); rs[h] = rsqrtf(((s4[0] + s4[1]) + (s4[2] + s4[3])) * (1.0f / 256.0f) + EPS); }
            *(LAS f32x4*)(lds + LDS_RTAB + ti * 4096 + tid * 16) = (f32x4){rs[0] / rs[1], rs[1] / rs[2], rs[2] / rs[3], rs[3]}; }
    }
    __device__ __forceinline__ bool sub(f32x4 (&acc)[2][2][4][2], const HUnit& u, int ui, int wr, int wc, int fr, int fq, LAS unsigned char* lds) const {
        unsigned tb = (unsigned)(LDS_RTAB + (ui >> 2) * 4096 + (wr * 64 + fr) * 16 + u.hh * 4); asm volatile("" : "+v"(tb));
        if (u.hh < 3) {
#pragma unroll
            for (int ai = 0; ai < 2; ++ai)
#pragma unroll
                for (int m = 0; m < 4; ++m) { const float r = *(const LAS float*)(lds + tb + (ai * HALF + m * 16) * 16);
#pragma unroll
                    for (int bj = 0; bj < 2; ++bj)
#pragma unroll
                        for (int n = 0; n < 2; ++n) acc[ai][bj][m][n] = acc[ai][bj][m][n] * r; }
            return true;
        }
        const int col0 = u.pn * BM + wc * 32 + 8 * fq;
#pragma unroll
        for (int ai = 0; ai < 2; ++ai) {
            u32x2 gva[4][2];
#pragma unroll
            for (int m = 0; m < 4; ++m)
#pragma unroll
                for (int bj = 0; bj < 2; ++bj) gva[m][bj] = *(const u32x2*)(gate + gate_off(u.pm, u.pn, ai, m, bj, wr * 256 + wc * 64 + fq * 16 + fr));
#pragma unroll
            for (int m = 0; m < 4; ++m) { const int rl = ai * HALF + wr * 64 + m * 16 + fr; const float r = *(const LAS float*)(lds + tb + (ai * HALF + m * 16) * 16); const size_t row = (size_t)(u.pm * BM + rl);
#pragma unroll
                for (int bj = 0; bj < 2; ++bj) { const int col = col0 + bj * HALF;
                    float sg[8]; unpack_u8x8(gva[m][bj], sg);
                    const f32x4 v0 = acc[ai][bj][m][0] * r, v1 = acc[ai][bj][m][1] * r;
                    u32x4 w;
                    w.x = cvt_pk_bf16(sg[0] * v0[0], sg[1] * v0[1]); w.y = cvt_pk_bf16(sg[2] * v0[2], sg[3] * v0[3]);
                    w.z = cvt_pk_bf16(sg[4] * v1[0], sg[5] * v1[1]); w.w = cvt_pk_bf16(sg[6] * v1[2], sg[7] * v1[3]);
                    *(u32x4*)((unsigned char*)O + m1_off(u.pm, u.pn, ai, m, bj, wr * 256 + wc * 64 + fq * 16 + fr)) = w; } }
        }
        return false;
    }
};
struct EpiRetK {
    static constexpr bool PERM = true, SUBUNITS = false, KHOOK = true;
    const float* ssq; const unsigned char* gate; bf16_t* O;
    __device__ __forceinline__ void fill_table(const DUnit& u, int ti, int tid, LAS unsigned char* lds) const {
        if (tid < 256) { const float* sp = ssq + (size_t)(u.pm * BM + tid) * 16; float rs[4];
#pragma unroll
            for (int h = 0; h < 4; ++h) { const f32x4 s4 = *(const f32x4*)(sp + 4 * h); rs[h] = rsqrtf(((s4[0] + s4[1]) + (s4[2] + s4[3])) * (1.0f / 256.0f) + EPS); }
            *(LAS f32x4*)(lds + LDS_RTAB + ti * 4096 + tid * 16) = (f32x4){rs[0] / rs[1], rs[1] / rs[2], rs[2] / rs[3], rs[3]}; }
    }
    __device__ __forceinline__ void khook(f32x4 (&acc)[2][2][4][2], int ui, int t, int, int, LAS unsigned char* lds) const {
        int tid = threadIdx.x; asm volatile("" : "+v"(tid));
        const int wr = tid >> 8, fr = tid & 15;
        unsigned tb = (unsigned)(LDS_RTAB + ui * 4096 + (wr * 64 + fr) * 16 + ((t >> 2) - 1) * 4); asm volatile("" : "+v"(tb));
#pragma unroll
        for (int ai = 0; ai < 2; ++ai)
#pragma unroll
            for (int m = 0; m < 4; ++m) { const float r = *(const LAS float*)(lds + tb + (ai * HALF + m * 16) * 16);
#pragma unroll
                for (int bj = 0; bj < 2; ++bj)
#pragma unroll
                    for (int n = 0; n < 2; ++n) acc[ai][bj][m][n] = acc[ai][bj][m][n] * r; }
    }
    __device__ __forceinline__ void operator()(const f32x4 (&acc)[2][2][4][2], const DUnit& u, int wr, int wc, int fr, int fq) const { }
    __device__ __forceinline__ void fin(const f32x4 (&acc)[2][2][4][2], const DUnit& u, int ui, int, int, int, int, LAS unsigned char* lds) const {
        int tid = threadIdx.x; asm volatile("" : "+v"(tid));
        const int wr = tid >> 8, wc = (tid >> 6) & 3, fr = tid & 15, fq = (tid & 63) >> 4;
        unsigned tb = (unsigned)(LDS_RTAB + ui * 4096 + (wr * 64 + fr) * 16 + 12); asm volatile("" : "+v"(tb));
        const int col0 = u.pn * BM + wc * 32 + 8 * fq;
#pragma unroll
        for (int ai = 0; ai < 2; ++ai) {
            u32x2 gva[4][2];
#pragma unroll
            for (int m = 0; m < 4; ++m)
#pragma unroll
                for (int bj = 0; bj < 2; ++bj) gva[m][bj] = *(const u32x2*)(gate + gate_off(u.pm, u.pn, ai, m, bj, wr * 256 + wc * 64 + fq * 16 + fr));
#pragma unroll
            for (int m = 0; m < 4; ++m) { const int rl = ai * HALF + wr * 64 + m * 16 + fr; const float r = *(const LAS float*)(lds + tb + (ai * HALF + m * 16) * 16); const size_t row = (size_t)(u.pm * BM + rl);
#pragma unroll
                for (int bj = 0; bj < 2; ++bj) { const int col = col0 + bj * HALF;
                    float sg[8]; unpack_u8x8(gva[m][bj], sg);
                    const f32x4 v0 = acc[ai][bj][m][0] * r, v1 = acc[ai][bj][m][1] * r;
                    u32x4 w;
                    w.x = cvt_pk_bf16(sg[0] * v0[0], sg[1] * v0[1]); w.y = cvt_pk_bf16(sg[2] * v0[2], sg[3] * v0[3]);
                    w.z = cvt_pk_bf16(sg[4] * v1[0], sg[5] * v1[1]); w.w = cvt_pk_bf16(sg[6] * v1[2], sg[7] * v1[3]);
                    *(u32x4*)((unsigned char*)O + m1_off(u.pm, u.pn, ai, m, bj, wr * 256 + wc * 64 + fq * 16 + fr)) = w; } }
        }
    }
};
template <bool ADD>
struct EpiGate {
    static constexpr bool PERM = true, SUBUNITS = false;
    const unsigned char* gate; int ldg; const bf16_t* base; int ldb; bf16_t* O; int ldc;
    __device__ __forceinline__ void operator()(const f32x4 (&acc)[2][2][4][2], const DUnit& u, int wr, int wc, int fr, int fq) const {
        const int row0 = u.pm * BM + wr * 64 + fr, col0 = u.pn * BM + wc * 32 + 8 * fq;
#pragma unroll
        for (int ai = 0; ai < 2; ++ai) {
            u32x2 gv[4][2]; u32x4 bv[4][2];
#pragma unroll
            for (int m = 0; m < 4; ++m)
#pragma unroll
                for (int bj = 0; bj < 2; ++bj) { const size_t row = (size_t)(row0 + ai * HALF + m * 16); const int col = col0 + bj * HALF;
                    gv[m][bj] = *(const u32x2*)(gate + gate_off(u.pm, ldg + u.pn, ai, m, bj, wr * 256 + wc * 64 + fq * 16 + fr)); bv[m][bj] = (u32x4){0u, 0u, 0u, 0u}; if (ADD) bv[m][bj] = *(const u32x4*)((const unsigned char*)base + m1_off(u.pm, u.pn, ai, m, bj, wr * 256 + wc * 64 + fq * 16 + fr)); }
#pragma unroll
            for (int m = 0; m < 4; ++m)
#pragma unroll
                for (int bj = 0; bj < 2; ++bj) { const size_t row = (size_t)(row0 + ai * HALF + m * 16); const int col = col0 + bj * HALF;
                    const u32x4 bb = bv[m][bj]; float sg[8]; unpack_u8x8(gv[m][bj], sg);
                    const f32x4 v0 = acc[ai][bj][m][0], v1 = acc[ai][bj][m][1];
                    float o[8];
                    o[0] = sg[0] * v0[0]; o[1] = sg[1] * v0[1]; o[2] = sg[2] * v0[2]; o[3] = sg[3] * v0[3];
                    o[4] = sg[4] * v1[0]; o[5] = sg[5] * v1[1]; o[6] = sg[6] * v1[2]; o[7] = sg[7] * v1[3];
                    if (ADD) { o[0] += bflo(bb.x); o[1] += bfhi(bb.x); o[2] += bflo(bb.y); o[3] += bfhi(bb.y); o[4] += bflo(bb.z); o[5] += bfhi(bb.z); o[6] += bflo(bb.w); o[7] += bfhi(bb.w); }
                    u32x4 w; w.x = cvt_pk_bf16(o[0], o[1]); w.y = cvt_pk_bf16(o[2], o[3]); w.z = cvt_pk_bf16(o[4], o[5]); w.w = cvt_pk_bf16(o[6], o[7]);
                    *(u32x4*)(O + row * ldc + col) = w; }
        }
    }
};
template <bool F32IN>
struct EpiResid {
    static constexpr bool PERM = true, SUBUNITS = false, PROBE2 = false;
    const float* xin32; const bf16_t* xin16; bf16_t* xout; const float* gvec;
    __device__ __forceinline__ void operator()(const f32x4 (&acc)[2][2][4][2], const DUnit& u, int wr, int wc, int fr, int fq) const {
        { int tid_ = threadIdx.x; asm volatile("" : "+v"(tid_)); wr = tid_ >> 8; wc = (tid_ >> 6) & 3; fr = tid_ & 15; fq = (tid_ & 63) >> 4; }
        const int row0 = u.pm * BM + wr * 64 + fr, col0 = u.pn * BM + wc * 32 + 8 * fq;
        const float* gp = gvec + (size_t)(u.pm >> 3) * 6144 + col0;
        f32x4 gv[2][2];
#pragma unroll
        for (int bj = 0; bj < 2; ++bj)
#pragma unroll
            for (int n = 0; n < 2; ++n) gv[bj][n] = *(const f32x4*)(gp + bj * HALF + n * 4);
#pragma unroll
        for (int ai = 0; ai < 2; ++ai) {
            f32x4 xv[4][2][2];
#pragma unroll
            for (int m = 0; m < 4; ++m)
#pragma unroll
                for (int bj = 0; bj < 2; ++bj) { const size_t off = (size_t)(row0 + ai * HALF + m * 16) * D + col0 + bj * HALF;
                    if (F32IN) { xv[m][bj][0] = *(const f32x4*)(xin32 + off); xv[m][bj][1] = *(const f32x4*)(xin32 + off + 4); }
                    else { const u32x4 xb = *(const u32x4*)(xin16 + off); xv[m][bj][0] = (f32x4){bflo(xb.x), bfhi(xb.x), bflo(xb.y), bfhi(xb.y)}; xv[m][bj][1] = (f32x4){bflo(xb.z), bfhi(xb.z), bflo(xb.w), bfhi(xb.w)}; } }
#pragma unroll
            for (int m = 0; m < 4; ++m)
#pragma unroll
                for (int bj = 0; bj < 2; ++bj) { const size_t off = (size_t)(row0 + ai * HALF + m * 16) * D + col0 + bj * HALF;
                    const f32x4 o0 = xv[m][bj][0] + gv[bj][0] * acc[ai][bj][m][0], o1 = xv[m][bj][1] + gv[bj][1] * acc[ai][bj][m][1];
                    u32x4 w; w.x = cvt_pk_bf16(o0[0], o0[1]); w.y = cvt_pk_bf16(o0[2], o0[3]); w.z = cvt_pk_bf16(o1[0], o1[1]); w.w = cvt_pk_bf16(o1[2], o1[3]);
                    *(u32x4*)(xout + off) = w; }
        }
    }
};
struct EpiGateUp {
    static constexpr bool PERM = true, SUBUNITS = false;
    bf16_t* act;
    __device__ __forceinline__ void operator()(const f32x4 (&acc)[2][2][4][2], const MUnit& u, int wr, int wc, int fr, int fq) const {
        const int r0 = wr * 64 + fr, col0 = u.pn * HALF + wc * 32 + 8 * fq;
#pragma unroll
        for (int ai = 0; ai < 2; ++ai)
#pragma unroll
            for (int m = 0; m < 4; ++m) { const int r = r0 + ai * HALF + m * 16;
                if (u.pos0 + r < u.cnt) {
                    const f32x4 g0 = acc[ai][0][m][0], g1 = acc[ai][0][m][1], u0 = acc[ai][1][m][0], u1 = acc[ai][1][m][1];
                    u32x4 w; w.x = cvt_pk_bf16(silu_f(g0[0]) * u0[0], silu_f(g0[1]) * u0[1]); w.y = cvt_pk_bf16(silu_f(g0[2]) * u0[2], silu_f(g0[3]) * u0[3]);
                    w.z = cvt_pk_bf16(silu_f(g1[0]) * u1[0], silu_f(g1[1]) * u1[1]); w.w = cvt_pk_bf16(silu_f(g1[2]) * u1[2], silu_f(g1[3]) * u1[3]);
                    *(u32x4*)(act + (size_t)(u.pm * BM + r) * DE + col0) = w; } }
    }
};
struct EpiDown {
    static constexpr bool PERM = true, SUBUNITS = false;
    bf16_t* ybuf; const int* stok; const float* sw;
    __device__ __forceinline__ void operator()(const f32x4 (&acc)[2][2][4][2], const MUnit& u, int wr, int wc, int fr, int fq) const {
        const int r0 = wr * 64 + fr, col0 = u.pn * BM + wc * 32 + 8 * fq;
#pragma unroll
        for (int ai = 0; ai < 2; ++ai)
#pragma unroll
            for (int m = 0; m < 4; ++m) { const int r = r0 + ai * HALF + m * 16;
                if (u.pos0 + r < u.cnt) {
                    const size_t si = (size_t)u.e * CAP + u.pos0 + r; const int meta = stok[si]; const float wv = sw[si];
                    bf16_t* rowp = ybuf + (size_t)meta * D + col0;
#pragma unroll
                    for (int bj = 0; bj < 2; ++bj) { const f32x4 v0 = acc[ai][bj][m][0] * wv, v1 = acc[ai][bj][m][1] * wv;
                        u32x4 w; w.x = cvt_pk_bf16(v0[0], v0[1]); w.y = cvt_pk_bf16(v0[2], v0[3]); w.z = cvt_pk_bf16(v1[0], v1[1]); w.w = cvt_pk_bf16(v1[2], v1[3]);
                        *(u32x4*)(rowp + bj * HALF) = w; } } }
    }
};
}

struct Params {
    const float *x, *c, *w_ada, *b_ada, *n1g, *n2g, *w_in, *w_ret_o, *pool_w, *pool_scale, *w_pool_o, *w_out, *w_router, *b_router, *w_eg, *w_eu, *w_ed, *final_g;
    float* out; unsigned char* ws; int ph_lo, ph_hi;
};

struct Ctx {
    LAS unsigned char* lds; int tid, lane, wave, G, bx;
};
__device__ __forceinline__ Ctx make_ctx(LAS unsigned char* lds) {
    Ctx F; int t = threadIdx.x; asm volatile("" : "+v"(t)); int bx = blockIdx.x; asm volatile("" : "+s"(bx));
    F.lds = lds; F.tid = t; F.lane = t & 63; F.wave = rfl(t >> 6); F.G = gridDim.x; F.bx = bx; return F;
}

__device__ __forceinline__ void phase_prologue(const Params& p, const Ctx& F) {
    LAS float* cond = (LAS float*)F.lds;
    LAS float* red = (LAS float*)(F.lds + 65536);
    for (int i = F.tid; i < NB * D; i += NTHR) { const float v = p.c[i]; cond[i] = silu_f(v); }
    __syncthreads();
    float* mod = (float*)(p.ws + WS_MOD);
    for (int item = F.bx; item < DEPTH * 96; item += F.G) {
        const int l = item / 96, jb = item % 96;
        const float* w = p.w_ada + (size_t)l * D * 6144 + jb * 64 + F.lane;
        float acc[NB];
#pragma unroll
        for (int b = 0; b < NB; ++b) acc[b] = 0.f;
#pragma unroll 4
        for (int dd = 0; dd < 128; ++dd) { const int d = F.wave * 128 + dd; const float wv = w[(size_t)d * 6144];
#pragma unroll
            for (int b = 0; b < NB; ++b) acc[b] += cond[b * D + d] * wv; }
#pragma unroll
        for (int b = 0; b < NB; ++b) red[(F.wave * NB + b) * 64 + F.lane] = acc[b];
        __syncthreads();
        for (int o = F.tid; o < NB * 64; o += NTHR) { const int b = o >> 6, ln = o & 63; float s = 0.f;
#pragma unroll
            for (int w8 = 0; w8 < 8; ++w8) s += red[(w8 * NB + b) * 64 + ln];
            mod[(size_t)(l * NB + b) * 6144 + jb * 64 + ln] = s + p.b_ada[l * 6144 + jb * 64 + ln]; }
        __syncthreads();
    }
    float* cosT = (float*)(p.ws + WS_ROPE); float* sinT = cosT + SEQ * 64;
    for (int i = F.bx * NTHR + F.tid; i < SEQ * 64; i += F.G * NTHR) { const int pos = i >> 6, fi = i & 63;
        const float freq = exp2f(-(float)fi * (13.287712379549449f / 64.0f));
        const float ang = (float)pos * freq;
        const float rev = ang * 0.15915494309189535f; const float fr = rev - floorf(rev);
        cosT[i] = __builtin_amdgcn_cosf(fr); sinT[i] = __builtin_amdgcn_sinf(fr); }
    float* dq = (float*)(p.ws + WS_DEC); float* dk = dq + 4 * SEQ;
    for (int i = F.bx * NTHR + F.tid; i < 4 * SEQ; i += F.G * NTHR) { const int h = i >> 11, pos = i & (SEQ - 1);
        const float lg = log2f(1.0f - exp2f(-5.0f - (float)h)); dq[i] = exp2f(lg * (float)pos); dk[i] = exp2f(-lg * (float)pos); }
}

__device__ __forceinline__ void transpose_item(const float* W, int N, bf16_t* WT, int Kd, int k0, int n0, int drow0, LAS float* scr, int lane, int rot = 0, int i0 = 0, int rot_half = 0, float scale = 1.0f) {
#pragma unroll 8
    for (int i = 0; i < 32; ++i) { const int kk = 2 * i + (lane >> 5); scr[kk * 33 + (lane & 31)] = W[(size_t)(k0 + kk) * N + n0 + (lane & 31)]; }
    asm volatile("s_waitcnt lgkmcnt(0)" ::: "memory");
    const int c = lane & 7;
#pragma unroll
    for (int j = 0; j < 4; ++j) { const int n = (lane >> 3) + 8 * j; const LAS float* s = scr + (8 * c) * 33 + n;
        u32x4 o; o.x = cvt_pk_bf16(s[0 * 33] * scale, s[1 * 33] * scale); o.y = cvt_pk_bf16(s[2 * 33] * scale, s[3 * 33] * scale); o.z = cvt_pk_bf16(s[4 * 33] * scale, s[5 * 33] * scale); o.w = cvt_pk_bf16(s[6 * 33] * scale, s[7 * 33] * scale);
        const int ii = i0 + n; const int drow = rot ? drow0 + 32 * (ii >> 4) + 8 * ((ii >> 2) & 3) + 4 * rot_half + (ii & 3) : drow0 + n;
        *(u32x4*)(WT + (size_t)drow * Kd + k0 + 8 * c) = o; }
    asm volatile("s_waitcnt lgkmcnt(0)" ::: "memory");
}
__device__ __forceinline__ void transpose_item64(const float* W, int N, bf16_t* WT, int Kd, int k0, int n0, int drow0, LAS float* scr, int lane) {
    const float* src = W + (size_t)k0 * N + n0 + lane;
#pragma unroll 16
    for (int kk = 0; kk < 64; ++kk) scr[kk * 65 + lane] = src[(size_t)kk * N];
    asm volatile("s_waitcnt lgkmcnt(0)" ::: "memory");
    const int c = lane & 7;
#pragma unroll
    for (int j = 0; j < 8; ++j) { const int n = (lane >> 3) + 8 * j; const LAS float* s = scr + (8 * c) * 65 + n;
        u32x4 o; o.x = cvt_pk_bf16(s[0 * 65], s[1 * 65]); o.y = cvt_pk_bf16(s[2 * 65], s[3 * 65]); o.z = cvt_pk_bf16(s[4 * 65], s[5 * 65]); o.w = cvt_pk_bf16(s[6 * 65], s[7 * 65]);
        *(u32x4*)(WT + (size_t)(drow0 + n) * Kd + k0 + 8 * c) = o; }
    asm volatile("s_waitcnt lgkmcnt(0)" ::: "memory");
}
__device__ __forceinline__ void convert_layer_weights(const Params& p, const Ctx& F, int l) {
    LAS float* scr = (LAS float*)(F.lds + F.wave * 17408);
    const int gw = F.bx * NWAVES + F.wave, NGW = F.G * NWAVES;
    constexpr int I_QK = 16 * 32, I_IN = 16 * 72, I_RO = 16 * 16, I_OUT = 16 * 16, I_G = 16 * 16 * 8, I_U = I_G, I_DN = 16 * 8 * 16, I_PE = 4 * 16 * 32;
    constexpr int NITEMS = I_QK + I_IN + I_RO + I_OUT + I_G + I_U + I_DN + I_PE;
    unsigned char* ws = p.ws;
    for (int it = gw; it < NITEMS; it += NGW) {
        int r = it;
        if (r < I_QK) { const int kb = r / 32, nb = r % 32; const int n0 = nb * 32;
            transpose_item(p.w_in + (size_t)l * D * INW, INW, (bf16_t*)(ws + WT_IN), D, kb * 64, n0, n0 & ~127, scr, F.lane, 1, n0 & 63, (n0 >> 6) & 1, n0 >= 512 ? 0.08838834764831845f : 1.0f);
            continue; } r -= I_QK;
        if (r < I_IN) { const int kb = r / 72, nb = r % 72; const int n0 = 1024 + nb * 64;
            transpose_item64(p.w_in + (size_t)l * D * INW, INW, (bf16_t*)(ws + WT_IN), D, kb * 64, n0, n0, scr, F.lane); continue; } r -= I_IN;
        if (r < I_RO) { const int kb = r / 16, nb = r % 16; transpose_item64(p.w_ret_o + (size_t)l * D * D, D, (bf16_t*)(ws + WT_RO), D, kb * 64, nb * 64, nb * 64, scr, F.lane); continue; } r -= I_RO;
        if (r < I_OUT) { const int kb = r / 16, nb = r % 16; transpose_item64(p.w_out + (size_t)l * D * D, D, (bf16_t*)(ws + WT_OUT), D, kb * 64, nb * 64, nb * 64, scr, F.lane); continue; } r -= I_OUT;
        if (r < I_G + I_U) { const int half = r / I_G; const int q = r % I_G; const int e = q / 128, kb = (q % 128) / 8, nb = q % 8; const int n0 = nb * 64;
            const float* W = (half ? p.w_eu : p.w_eg) + ((size_t)l * NE + e) * D * DE;
            transpose_item64(W, DE, (bf16_t*)(ws + WT_GU) + (size_t)e * 1024 * D, D, kb * 64, n0, (n0 >> 7) * 256 + half * 128 + (n0 & 127), scr, F.lane); continue; } r -= I_G + I_U;
        if (r < I_DN) { const int e = r / 128, kb = (r % 128) / 16, nb = r % 16;
            transpose_item64(p.w_ed + ((size_t)l * NE + e) * DE * D, D, (bf16_t*)(ws + WT_DN) + (size_t)e * D * DE, DE, kb * 64, nb * 64, nb * 64, scr, F.lane); continue; } r -= I_DN;
        {
            const int g = r / 512, nb = (r % 512) / 32, cb = r % 32; const int n = nb * 64 + F.lane, c0 = cb * 4;
            const float* pw = p.pool_w + ((size_t)(l * 4 + g) * 128 + c0) * 128; const float* ps = p.pool_scale + l * 512 + g * 128;
            for (int i = F.lane; i < 4 * 128; i += 64) scr[i] = pw[i] * ps[i & 127];
            asm volatile("s_waitcnt lgkmcnt(0)" ::: "memory");
            const float* wo = p.w_pool_o + ((size_t)l * 512 + g * 128) * D + n;
            float acc[4];
#pragma unroll
            for (int c = 0; c < 4; ++c) acc[c] = 0.f;
            for (int d0 = 0; d0 < 128; d0 += 32) {
                float tv[32];
#pragma unroll
                for (int i = 0; i < 32; ++i) tv[i] = wo[(size_t)(d0 + i) * D];
#pragma unroll
                for (int i = 0; i < 32; ++i)
#pragma unroll
                    for (int c = 0; c < 4; ++c) acc[c] += scr[c * 128 + d0 + i] * tv[i]; }
            u32x2 o0; o0.x = cvt_pk_bf16(acc[0], acc[1]); o0.y = cvt_pk_bf16(acc[2], acc[3]);
            *(u32x2*)((bf16_t*)(ws + WT_PE) + (size_t)n * 512 + g * 128 + c0) = o0;
            asm volatile("s_waitcnt lgkmcnt(0)" ::: "memory");
        }
    }
}

__device__ __forceinline__ void phase_norm1(const Params& p, const Ctx& F, int l, int nrep) {
    for (int rep = 0; rep < NREP(0); ++rep) convert_layer_weights(p, F, l);
    const float* mod = (const float*)(p.ws + WS_MOD);
    const bf16_t* ybuf = (const bf16_t*)(p.ws + WS_YBUF);
    bf16_t* H = (bf16_t*)(p.ws + WS_H);
    bf16_t* XB = (bf16_t*)(p.ws + WS_XB);
    const int gw = F.bx * NWAVES + F.wave, NGW = F.G * NWAVES;
    for (int rep = 0; rep < nrep; ++rep)
    for (int blk = gw; blk < T / 16; blk += NGW) {
        const bool dummy = rep + 1 < nrep;
        const int row0 = blk * 16, b = row0 / SEQ;
        const float* m1 = mod + (size_t)(l * NB + b) * 6144;
        f32x4 av[4], cv[4], g2v[4];
#pragma unroll
        for (int i = 0; i < 4; ++i) { const int d = i * 256 + F.lane * 4;
            const f32x4 g = *(const f32x4*)(p.n1g + l * D + d), sc = *(const f32x4*)(m1 + 1024 + d);
            av[i] = g * (sc + 1.0f); cv[i] = *(const f32x4*)(m1 + d);
            g2v[i] = (f32x4){0.f, 0.f, 0.f, 0.f};
            if (l > 0) g2v[i] = *(const f32x4*)(mod + (size_t)((l - 1) * NB + b) * 6144 + 5120 + d); }
        f32x4 nf[4]; u32x2 nxb[4], ny0[4], ny1[4];
#pragma unroll
        for (int i = 0; i < 4; ++i) { const int d = i * 256 + F.lane * 4; const size_t row = (size_t)row0;
            if (l == 0) nf[i] = *(const f32x4*)(p.x + row * D + d);
            else { nxb[i] = *(const u32x2*)(XB + row * D + d); ny0[i] = *(const u32x2*)(ybuf + (2 * row) * D + d); ny1[i] = *(const u32x2*)(ybuf + (2 * row + 1) * D + d); } }
        for (int r = 0; r < 16; ++r) {
            const size_t row = (size_t)(row0 + r);
            f32x4 v[4]; u32x2 y0[4], y1[4]; float ss = 0.f;
#pragma unroll
            for (int i = 0; i < 4; ++i) { if (l == 0) v[i] = nf[i]; else { v[i] = (f32x4){bflo(nxb[i].x), bfhi(nxb[i].x), bflo(nxb[i].y), bfhi(nxb[i].y)}; y0[i] = ny0[i]; y1[i] = ny1[i]; } }
            if (r + 1 < 16) {
#pragma unroll
                for (int i = 0; i < 4; ++i) { const int d = i * 256 + F.lane * 4; const size_t rn = row + 1;
                    if (l == 0) nf[i] = *(const f32x4*)(p.x + rn * D + d);
                    else { nxb[i] = *(const u32x2*)(XB + rn * D + d); ny0[i] = *(const u32x2*)(ybuf + (2 * rn) * D + d); ny1[i] = *(const u32x2*)(ybuf + (2 * rn + 1) * D + d); } } }
#pragma unroll
            for (int i = 0; i < 4; ++i) { const int d = i * 256 + F.lane * 4;
                if (l != 0) {
                    f32x4 ys; ys[0] = bflo(y0[i].x) + bflo(y1[i].x); ys[1] = bfhi(y0[i].x) + bfhi(y1[i].x); ys[2] = bflo(y0[i].y) + bflo(y1[i].y); ys[3] = bfhi(y0[i].y) + bfhi(y1[i].y);
                    v[i] = v[i] + g2v[i] * ys;
                    if (!dummy) { u32x2 xw; xw.x = cvt_pk_bf16(v[i][0], v[i][1]); xw.y = cvt_pk_bf16(v[i][2], v[i][3]); *(u32x2*)(XB + row * D + d) = xw; } }
                ss += (v[i][0] * v[i][0] + v[i][1] * v[i][1]) + (v[i][2] * v[i][2] + v[i][3] * v[i][3]); }
            const float rstd = rsqrtf(wave_sum(ss) * (1.0f / D) + EPS);
#pragma unroll
            for (int i = 0; i < 4; ++i) { const int d = i * 256 + F.lane * 4; const f32x4 h = v[i] * rstd * av[i] + cv[i];
                u32x2 w; w.x = cvt_pk_bf16(h[0], h[1]); w.y = cvt_pk_bf16(h[2], h[3]);
                *(u32x2*)(H + row * D + d) = w; }
        }
    }
}

constexpr int RSK = 272, RSV = 144;
typedef short s16x4 __attribute__((ext_vector_type(4)));
__device__ __forceinline__ bf16x8 tr16x2(const LAS unsigned char* a0, const LAS unsigned char* a1) {
    const s16x4 lo = __builtin_amdgcn_ds_read_tr16_b64_v4i16((LAS s16x4*)a0), hi = __builtin_amdgcn_ds_read_tr16_b64_v4i16((LAS s16x4*)a1);
    return (bf16x8){lo[0], lo[1], lo[2], lo[3], hi[0], hi[1], hi[2], hi[3]};
}
__device__ __forceinline__ void phase_ret2(const Params& p, const Ctx& F, int vcu) {
    LAS unsigned char* Kim = F.lds;
    LAS unsigned char* Vim = F.lds + 34816;
    LAS unsigned char* StT = F.lds + 71680;
    LAS unsigned char* Pim = F.lds + 106496 + F.wave * (16 * RSK);
    bf16_t* P = (bf16_t*)(p.ws + WS_U);
    float* ssq = (float*)(p.ws + WS_SSQ);
    const int w = F.wave, fr = F.lane & 15, fg = F.lane >> 4, tq = fr >> 2, tp = F.lane & 3;
    unsigned oRow = (unsigned)(fr * RSK + 16 * fg), oPw = (unsigned)(fr * RSK + 8 * fg), oSw = (unsigned)(fr * RSK + 32 * w + 8 * fg);
    unsigned oTk = (unsigned)((8 * fg + tq) * RSK + 32 * w + 8 * tp), oTv = (unsigned)((8 * fg + tq) * RSV + 8 * tp), oTp = (unsigned)((4 * fg + tq) * RSV + 8 * tp);
    unsigned oKs = (unsigned)((F.tid >> 4) * RSK + (F.tid & 15) * 16), oVs = (unsigned)((F.tid >> 3) * RSV + (F.tid & 7) * 16);
    asm volatile("" : "+v"(oRow), "+v"(oPw), "+v"(oSw), "+v"(oTk), "+v"(oTv), "+v"(oKs), "+v"(oVs), "+v"(oTp));
    for (int rep2 = 0; rep2 < NREP(2); ++rep2) { const bool dummy = rep2 + 1 < NREP(2);
    for (int u = vcu; u < NB * 16; u += F.G) {
        const int s = u & 3, h = (u >> 2) & 3, b = u >> 4;
        __syncthreads();
        { unsigned z0 = 0u; asm volatile("" : "+v"(z0));
          for (int i = F.tid; i < 64 * RSK / 16; i += NTHR) *(LAS u32x4*)(StT + i * 16) = (u32x4){z0, z0, z0, z0}; }
        f32x4 st[4];
#pragma unroll
        for (int i = 0; i < 4; ++i) st[i] = (f32x4){0.f, 0.f, 0.f, 0.f};
        const size_t rowb = (size_t)b * SEQ;
        const bf16_t* kbase = (const bf16_t*)(p.ws + WS_KB) + (size_t)((b * 4 + h) * SEQ) * 128; const bf16_t* qbase = (const bf16_t*)(p.ws + WS_QB) + (size_t)((b * 4 + h) * SEQ) * 128;
        bf16_t* vbase = (bf16_t*)(p.ws + WS_VB) + (size_t)(((b * 4 + h) * 4 + s) * SEQ) * 64; const bf16_t* gbase = (const bf16_t*)(p.ws + WS_GB) + (size_t)(((b * 4 + h) * 4 + s) * SEQ) * 64;
        u32x4 kr[4], vr[2], qr[4];
#define RET_LOAD_CHUNK(nn) do { \
            _Pragma("unroll") for (int i_ = 0; i_ < 4; ++i_) { const int id_ = F.tid + NTHR * i_; kr[i_] = *(const u32x4*)(kbase + (size_t)((nn) * 128 + (id_ >> 4)) * 128 + (id_ & 15) * 8); } \
            _Pragma("unroll") for (int i_ = 0; i_ < 2; ++i_) { const int id_ = F.tid + NTHR * i_; vr[i_] = *(const u32x4*)(vbase + (size_t)((nn) * 128 + (id_ >> 3)) * 64 + (id_ & 7) * 8); } \
            _Pragma("unroll") for (int k_ = 0; k_ < 4; ++k_) qr[k_] = *(const u32x4*)(qbase + (size_t)((nn) * 128 + 16 * w + fr) * 128 + 32 * k_ + 8 * fg); } while (0)
        RET_LOAD_CHUNK(0);
        for (int n = 0; n < 16; ++n) {
#pragma unroll
            for (int i = 0; i < 4; ++i) *(LAS u32x4*)(Kim + oKs + i * 32 * RSK) = kr[i];
#pragma unroll
            for (int i = 0; i < 2; ++i) *(LAS u32x4*)(Vim + oVs + i * 64 * RSV) = vr[i];
            bf16x8 qf[4];
#pragma unroll
            for (int ks = 0; ks < 4; ++ks) qf[ks] = __builtin_bit_cast(bf16x8, qr[ks]);
            if (n + 1 < 16) RET_LOAD_CHUNK(n + 1);
            const size_t row = rowb + n * 128 + 16 * w + fr;
            u32x2 gr[4];
#pragma unroll
            for (int u4 = 0; u4 < 4; ++u4) gr[u4] = *(const u32x2*)(gbase + (size_t)(n * 128 + 16 * w + fr) * 64 + 16 * u4 + 4 * fg);
            __syncthreads();
            if (NREP(18) > 1) __syncthreads();
            const LAS unsigned char* Scur = StT + (n & 1) * (64 * RSK); LAS unsigned char* Snxt = StT + ((n + 1) & 1) * (64 * RSK);
            f32x4 yi[4];
#pragma unroll
            for (int i = 0; i < 4; ++i) yi[i] = (f32x4){0.f, 0.f, 0.f, 0.f};
#pragma unroll
            for (int kp = 0; kp < 4; ++kp) {
                if (2 * kp <= w) {
                    f32x4 a0 = (f32x4){0.f, 0.f, 0.f, 0.f}, a1 = (f32x4){0.f, 0.f, 0.f, 0.f};
#pragma unroll
                    for (int ks = 0; ks < 4; ++ks) { const bf16x8 kf = *(const LAS bf16x8*)(Kim + oRow + 32 * kp * RSK + 64 * ks); a0 = __builtin_amdgcn_mfma_f32_16x16x32_bf16(kf, qf[ks], a0, 0, 0, 0); }
                    if (2 * kp + 1 <= w) {
#pragma unroll
                        for (int ks = 0; ks < 4; ++ks) { const bf16x8 kf = *(const LAS bf16x8*)(Kim + oRow + (32 * kp + 16) * RSK + 64 * ks); a1 = __builtin_amdgcn_mfma_f32_16x16x32_bf16(kf, qf[ks], a1, 0, 0, 0); }
                    }
                    if (2 * kp == w) {
#pragma unroll
                        for (int r = 0; r < 4; ++r) a0[r] = (fr >= 4 * fg + r) ? a0[r] : 0.f; }
                    if (2 * kp + 1 == w) {
#pragma unroll
                        for (int r = 0; r < 4; ++r) a1[r] = (fr >= 4 * fg + r) ? a1[r] : 0.f; }
                    const bf16x8 pf = __builtin_bit_cast(bf16x8, (u32x4){cvt_pk_bf16(a0[0], a0[1]), cvt_pk_bf16(a0[2], a0[3]), cvt_pk_bf16(a1[0], a1[1]), cvt_pk_bf16(a1[2], a1[3])});
#pragma unroll
                    for (int u4 = 0; u4 < 4; ++u4) { const LAS unsigned char* va = Vim + oTp + 32 * kp * RSV + 32 * u4;
                        const bf16x8 vf = tr16x2(va, va + 16 * RSV); yi[u4] = __builtin_amdgcn_mfma_f32_16x16x32_bf16(vf, pf, yi[u4], 0, 0, 0); }
                }
            }
#pragma unroll
            for (int ks = 0; ks < 4; ++ks)
#pragma unroll
                for (int u4 = 0; u4 < 4; ++u4) { const bf16x8 sf = *(const LAS bf16x8*)(Scur + oRow + 16 * u4 * RSK + 64 * ks); yi[u4] = __builtin_amdgcn_mfma_f32_16x16x32_bf16(sf, qf[ks], yi[u4], 0, 0, 0); }
            if (NREP(16) > 1) {
                f32x4 yd[4];
#pragma unroll
                for (int i = 0; i < 4; ++i) yd[i] = (f32x4){0.f, 0.f, 0.f, 0.f};
#pragma unroll
                for (int kp = 0; kp < 4; ++kp) {
                    if (2 * kp <= w) {
                        f32x4 a0 = (f32x4){0.f, 0.f, 0.f, 0.f}, a1 = (f32x4){0.f, 0.f, 0.f, 0.f};
#pragma unroll
                        for (int ks = 0; ks < 4; ++ks) { const bf16x8 kf = *(const volatile LAS bf16x8*)(Kim + oRow + 32 * kp * RSK + 64 * ks); a0 = __builtin_amdgcn_mfma_f32_16x16x32_bf16(kf, qf[ks], a0, 0, 0, 0); }
                        if (2 * kp + 1 <= w) {
#pragma unroll
                            for (int ks = 0; ks < 4; ++ks) { const bf16x8 kf = *(const volatile LAS bf16x8*)(Kim + oRow + (32 * kp + 16) * RSK + 64 * ks); a1 = __builtin_amdgcn_mfma_f32_16x16x32_bf16(kf, qf[ks], a1, 0, 0, 0); }
                        }
                        const bf16x8 pf = __builtin_bit_cast(bf16x8, (u32x4){cvt_pk_bf16(a0[0], a0[1]), cvt_pk_bf16(a0[2], a0[3]), cvt_pk_bf16(a1[0], a1[1]), cvt_pk_bf16(a1[2], a1[3])});
#pragma unroll
                        for (int u4 = 0; u4 < 4; ++u4) { const LAS unsigned char* va = Vim + oTp + 32 * kp * RSV + 32 * u4;
                            const bf16x8 vf = tr16x2(va, va + 16 * RSV); yd[u4] = __builtin_amdgcn_mfma_f32_16x16x32_bf16(vf, pf, yd[u4], 0, 0, 0); }
                    }
                }
#pragma unroll
                for (int ks = 0; ks < 4; ++ks)
#pragma unroll
                    for (int u4 = 0; u4 < 4; ++u4) { const bf16x8 sf = *(const volatile LAS bf16x8*)(Scur + oRow + 16 * u4 * RSK + 64 * ks); yd[u4] = __builtin_amdgcn_mfma_f32_16x16x32_bf16(sf, qf[ks], yd[u4], 0, 0, 0); }
                asm volatile("" :: "v"(yd[0]), "v"(yd[1]), "v"(yd[2]), "v"(yd[3]));
            }
            {
                float ss = 0.f;
#pragma unroll
                for (int u4 = 0; u4 < 4; ++u4) { const f32x4 y = yi[u4]; ss += (y[0] * y[0] + y[1] * y[1]) + (y[2] * y[2] + y[3] * y[3]);
                    u32x2 yw; yw.x = cvt_pk_bf16(silu_f(bflo(gr[u4].x)) * y[0], silu_f(bfhi(gr[u4].x)) * y[1]); yw.y = cvt_pk_bf16(silu_f(bflo(gr[u4].y)) * y[2], silu_f(bfhi(gr[u4].y)) * y[3]);
                    if (dummy) *(u32x2*)((bf16_t*)(p.ws + WS_SCR) + row * D + h * 256 + s * 64 + 16 * u4 + 4 * fg) = yw;
                    else *(u32x2*)(vbase + (size_t)(n * 128 + 16 * w + fr) * 64 + 16 * u4 + 4 * fg) = yw; }
                ss += __shfl_xor(ss, 16); ss += __shfl_xor(ss, 32);
                if (fg == 0) ssq[row * 16 + h * 4 + s] = ss;
            }
#pragma unroll
            for (int ks = 0; ks < 4; ++ks) {
                const LAS unsigned char* ka = Kim + oTk + 32 * ks * RSK;
                const bf16x8 kz = tr16x2(ka, ka + 4 * RSK);
#pragma unroll
                for (int u4 = 0; u4 < 4; ++u4) { const LAS unsigned char* va = Vim + oTv + 32 * ks * RSV + 32 * u4;
                    const bf16x8 vz = tr16x2(va, va + 4 * RSV); st[u4] = __builtin_amdgcn_mfma_f32_16x16x32_bf16(kz, vz, st[u4], 0, 0, 0); }
            }
            if (NREP(17) > 1) {
                f32x4 sd[4];
#pragma unroll
                for (int i = 0; i < 4; ++i) sd[i] = (f32x4){0.f, 0.f, 0.f, 0.f};
#pragma unroll
                for (int ks = 0; ks < 4; ++ks) {
                    const LAS unsigned char* ka = Kim + oTk + 32 * ks * RSK;
                    const bf16x8 kz = tr16x2(ka, ka + 4 * RSK);
#pragma unroll
                    for (int u4 = 0; u4 < 4; ++u4) { const LAS unsigned char* va = Vim + oTv + 32 * ks * RSV + 32 * u4;
                        const bf16x8 vz = tr16x2(va, va + 4 * RSV); sd[u4] = __builtin_amdgcn_mfma_f32_16x16x32_bf16(kz, vz, sd[u4], 0, 0, 0); }
                }
                asm volatile("" :: "v"(sd[0]), "v"(sd[1]), "v"(sd[2]), "v"(sd[3]));
            }
#pragma unroll
            for (int u4 = 0; u4 < 4; ++u4) { u32x2 sw2; sw2.x = cvt_pk_bf16(st[u4][0], st[u4][1]); sw2.y = cvt_pk_bf16(st[u4][2], st[u4][3]);
                *(LAS u32x2*)(Snxt + oSw + 16 * u4 * RSK) = sw2; }
            __syncthreads();
        }
#undef RET_LOAD_CHUNK
    }
    }
    for (int rep3 = 0; rep3 < NREP(14); ++rep3) {
    bf16_t* MX = (bf16_t*)(p.ws + WS_H);
    const int gw = F.bx * NWAVES + F.wave, NGW = F.G * NWAVES;
    const int c = F.lane * 8, grp = F.lane >> 4, win = 2 << grp;
    for (int blk = gw; blk < T / 8; blk += NGW) {
        const int row0 = blk * 8; const int pos0 = row0 & (SEQ - 1);
        u32x4 R[23];
#pragma unroll
        for (int i = 0; i < 23; ++i) R[i] = *(const u32x4*)(P + ((long)(row0 - 15 + i) * 512) + c);
        if (pos0 < 15) {
#pragma unroll
            for (int i = 0; i < 15; ++i) if (pos0 - 15 + i < 0) R[i] = (u32x4){0u, 0u, 0u, 0u}; }
        float acc[8];
#pragma unroll
        for (int k = 0; k < 8; ++k) acc[k] = 0.f;
#pragma clang loop unroll(full)
        for (int j = 0; j < 16; ++j) { u32x4 uv = R[15 - j]; if (!(j < win)) uv = (u32x4){0u, 0u, 0u, 0u};
            acc[0] += bflo(uv.x); acc[1] += bfhi(uv.x); acc[2] += bflo(uv.y); acc[3] += bfhi(uv.y); acc[4] += bflo(uv.z); acc[5] += bfhi(uv.z); acc[6] += bflo(uv.w); acc[7] += bfhi(uv.w); }
#pragma clang loop unroll(full)
        for (int r = 0; r < 8; ++r) {
            const int pos = pos0 + r; const int cnt = (pos + 1) < win ? (pos + 1) : win;
            if (r > 0) { const u32x4 nv = R[15 + r]; const u32x4 o2 = R[13 + r], o4 = R[11 + r], o8 = R[7 + r], o16 = R[r - 1 < 0 ? 0 : r - 1];
                u32x4 ov = grp == 0 ? o2 : (grp == 1 ? o4 : (grp == 2 ? o8 : o16));
                acc[0] += bflo(nv.x) - bflo(ov.x); acc[1] += bfhi(nv.x) - bfhi(ov.x); acc[2] += bflo(nv.y) - bflo(ov.y); acc[3] += bfhi(nv.y) - bfhi(ov.y);
                acc[4] += bflo(nv.z) - bflo(ov.z); acc[5] += bfhi(nv.z) - bfhi(ov.z); acc[6] += bflo(nv.w) - bflo(ov.w); acc[7] += bfhi(nv.w) - bfhi(ov.w); }
            const u32x4 cu = R[15 + r]; const float inv = 1.0f / (float)cnt;
            u32x4 wv; wv.x = cvt_pk_bf16(acc[0] * inv - bflo(cu.x), acc[1] * inv - bfhi(cu.x)); wv.y = cvt_pk_bf16(acc[2] * inv - bflo(cu.y), acc[3] * inv - bfhi(cu.y));
            wv.z = cvt_pk_bf16(acc[4] * inv - bflo(cu.z), acc[5] * inv - bfhi(cu.z)); wv.w = cvt_pk_bf16(acc[6] * inv - bflo(cu.w), acc[7] * inv - bfhi(cu.w));
            *(u32x4*)(MX + (size_t)(row0 + r) * 512 + c) = wv;
        }
    }
    }
}

__device__ __forceinline__ void phase_ret3(const Params& p, const Ctx& F, int vcu) {
    LAS unsigned char* Kb = F.lds;
    LAS unsigned char* Vb = F.lds + 65536;
    LAS unsigned char* StT = F.lds + 98304;
    bf16_t* P = (bf16_t*)(p.ws + WS_U);
    float* ssq = (float*)(p.ws + WS_SSQ);
    const int w = F.wave, lane = F.lane, fr = lane & 15, fg = lane >> 4, tq = fr >> 2, tp = lane & 3;
    unsigned oK0 = (unsigned)(fr * 256 + (((0 + fg) ^ fr) << 4)), oK1 = (unsigned)(fr * 256 + (((4 + fg) ^ fr) << 4)), oK2 = (unsigned)(fr * 256 + (((8 + fg) ^ fr) << 4)), oK3 = (unsigned)(fr * 256 + (((12 + fg) ^ fr) << 4));
    unsigned oKt = (unsigned)((4 * fg + tq) * 256 + (((2 * w + (tp >> 1)) ^ (4 * fg + tq)) << 4) + 8 * (tp & 1));
    unsigned oV0 = (unsigned)((4 * fg + tq) * 128 + (((0 + (tp >> 1)) ^ (4 * (fg & 1) + tq)) << 4) + 8 * (tp & 1)), oV1 = (unsigned)((4 * fg + tq) * 128 + (((2 + (tp >> 1)) ^ (4 * (fg & 1) + tq)) << 4) + 8 * (tp & 1));
    unsigned oV2 = (unsigned)((4 * fg + tq) * 128 + (((4 + (tp >> 1)) ^ (4 * (fg & 1) + tq)) << 4) + 8 * (tp & 1)), oV3 = (unsigned)((4 * fg + tq) * 128 + (((6 + (tp >> 1)) ^ (4 * (fg & 1) + tq)) << 4) + 8 * (tp & 1));
    unsigned oRow = (unsigned)(fr * RSK + 16 * fg), oSw = (unsigned)(fr * RSK + 32 * w + 8 * fg);
    asm volatile("" : "+v"(oK0), "+v"(oK1), "+v"(oK2), "+v"(oK3), "+v"(oKt), "+v"(oV0), "+v"(oV1), "+v"(oV2), "+v"(oV3), "+v"(oRow), "+v"(oSw));
    const int krow = lane >> 4, kch = lane & 15, vrow = lane >> 3, vch = lane & 7;
    for (int rep2 = 0; rep2 < NREP(2); ++rep2) { const bool dummy = rep2 + 1 < NREP(2);
    for (int u = vcu; u < NB * 16; u += F.G) {
        const int s = u & 3, h = (u >> 2) & 3, b = u >> 4;
        __syncthreads();
        { unsigned z0 = 0u; asm volatile("" : "+v"(z0));
          for (int i = F.tid; i < 64 * RSK / 16; i += NTHR) *(LAS u32x4*)(StT + i * 16) = (u32x4){z0, z0, z0, z0}; }
        f32x4 st[4];
#pragma unroll
        for (int i = 0; i < 4; ++i) st[i] = (f32x4){0.f, 0.f, 0.f, 0.f};
        const size_t rowb = (size_t)b * SEQ;
        const bf16_t* kbase = (const bf16_t*)(p.ws + WS_KB) + (size_t)((b * 4 + h) * SEQ) * 128; const bf16_t* qbase = (const bf16_t*)(p.ws + WS_QB) + (size_t)((b * 4 + h) * SEQ) * 128;
        bf16_t* vbase = (bf16_t*)(p.ws + WS_VB) + (size_t)(((b * 4 + h) * 4 + s) * SEQ) * 64; const bf16_t* gbase = (const bf16_t*)(p.ws + WS_GB) + (size_t)(((b * 4 + h) * 4 + s) * SEQ) * 64;
        u32x4 qr[4]; u32x2 grn[4];
#define RET_ISSUE(nn) do { \
            _Pragma("unroll") for (int i_ = 0; i_ < 4; ++i_) { const int r_ = 16 * w + 4 * i_ + krow; \
                __builtin_amdgcn_global_load_lds((const unsigned*)(kbase + (size_t)((nn) * 128 + r_) * 128 + ((kch ^ (r_ & 15)) << 3)), (LAS unsigned*)(Kb + ((nn) & 1) * 32768 + (16 * w + 4 * i_) * 256), 16, 0, 0); } \
            _Pragma("unroll") for (int i_ = 0; i_ < 2; ++i_) { const int r_ = 16 * w + 8 * i_ + vrow; \
                __builtin_amdgcn_global_load_lds((const unsigned*)(vbase + (size_t)((nn) * 128 + r_) * 64 + ((vch ^ (r_ & 7)) << 3)), (LAS unsigned*)(Vb + ((nn) & 1) * 16384 + (16 * w + 8 * i_) * 128), 16, 0, 0); } \
            _Pragma("unroll") for (int k_ = 0; k_ < 4; ++k_) qr[k_] = *(const u32x4*)(qbase + (size_t)((nn) * 128 + 16 * w + fr) * 128 + 32 * k_ + 8 * fg); \
            _Pragma("unroll") for (int u_ = 0; u_ < 4; ++u_) grn[u_] = *(const u32x2*)(gbase + (size_t)((nn) * 128 + 16 * w + fr) * 64 + 16 * u_ + 4 * fg); } while (0)
        RET_ISSUE(0);
        bf16x8 qf[4]; u32x2 gr[4];
#pragma unroll
        for (int ks = 0; ks < 4; ++ks) qf[ks] = __builtin_bit_cast(bf16x8, qr[ks]);
#pragma unroll
        for (int u4 = 0; u4 < 4; ++u4) gr[u4] = grn[u4];
        asm volatile("s_waitcnt vmcnt(0) lgkmcnt(0)" ::: "memory");
        for (int n = 0; n < 16; ++n) {
            __builtin_amdgcn_s_barrier();
            asm volatile("" ::: "memory");
            if (n + 1 < 16) RET_ISSUE(n + 1);
            const LAS unsigned char* Kim = Kb + (n & 1) * 32768; const LAS unsigned char* Vim = Vb + (n & 1) * 16384;
            const LAS unsigned char* Scur = StT + (n & 1) * (64 * RSK); LAS unsigned char* Snxt = StT + ((n + 1) & 1) * (64 * RSK);
            const size_t row = rowb + n * 128 + 16 * w + fr;
            f32x4 yi[4];
#pragma unroll
            for (int i = 0; i < 4; ++i) yi[i] = (f32x4){0.f, 0.f, 0.f, 0.f};
#pragma unroll
            for (int kp = 0; kp < 4; ++kp) {
                if (2 * kp <= w) {
                    f32x4 a0 = (f32x4){0.f, 0.f, 0.f, 0.f}, a1 = (f32x4){0.f, 0.f, 0.f, 0.f};
                    { const bf16x8 k0 = *(const LAS bf16x8*)(Kim + oK0 + 32 * kp * 256), k1 = *(const LAS bf16x8*)(Kim + oK1 + 32 * kp * 256), k2 = *(const LAS bf16x8*)(Kim + oK2 + 32 * kp * 256), k3 = *(const LAS bf16x8*)(Kim + oK3 + 32 * kp * 256);
                      a0 = __builtin_amdgcn_mfma_f32_16x16x32_bf16(k0, qf[0], a0, 0, 0, 0); a0 = __builtin_amdgcn_mfma_f32_16x16x32_bf16(k1, qf[1], a0, 0, 0, 0);
                      a0 = __builtin_amdgcn_mfma_f32_16x16x32_bf16(k2, qf[2], a0, 0, 0, 0); a0 = __builtin_amdgcn_mfma_f32_16x16x32_bf16(k3, qf[3], a0, 0, 0, 0); }
                    if (2 * kp + 1 <= w) {
                      const bf16x8 k0 = *(const LAS bf16x8*)(Kim + oK0 + (32 * kp + 16) * 256), k1 = *(const LAS bf16x8*)(Kim + oK1 + (32 * kp + 16) * 256), k2 = *(const LAS bf16x8*)(Kim + oK2 + (32 * kp + 16) * 256), k3 = *(const LAS bf16x8*)(Kim + oK3 + (32 * kp + 16) * 256);
                      a1 = __builtin_amdgcn_mfma_f32_16x16x32_bf16(k0, qf[0], a1, 0, 0, 0); a1 = __builtin_amdgcn_mfma_f32_16x16x32_bf16(k1, qf[1], a1, 0, 0, 0);
                      a1 = __builtin_amdgcn_mfma_f32_16x16x32_bf16(k2, qf[2], a1, 0, 0, 0); a1 = __builtin_amdgcn_mfma_f32_16x16x32_bf16(k3, qf[3], a1, 0, 0, 0); }
                    if (2 * kp == w) {
#pragma unroll
                        for (int r = 0; r < 4; ++r) a0[r] = (fr >= 4 * fg + r) ? a0[r] : 0.f; }
                    if (2 * kp + 1 == w) {
#pragma unroll
                        for (int r = 0; r < 4; ++r) a1[r] = (fr >= 4 * fg + r) ? a1[r] : 0.f; }
                    const bf16x8 pf = __builtin_bit_cast(bf16x8, (u32x4){cvt_pk_bf16(a0[0], a0[1]), cvt_pk_bf16(a0[2], a0[3]), cvt_pk_bf16(a1[0], a1[1]), cvt_pk_bf16(a1[2], a1[3])});
                    { const LAS unsigned char* v0 = Vim + oV0 + 32 * kp * 128; const LAS unsigned char* v1 = Vim + oV1 + 32 * kp * 128; const LAS unsigned char* v2 = Vim + oV2 + 32 * kp * 128; const LAS unsigned char* v3 = Vim + oV3 + 32 * kp * 128;
                      yi[0] = __builtin_amdgcn_mfma_f32_16x16x32_bf16(tr16x2(v0, v0 + 16 * 128), pf, yi[0], 0, 0, 0); yi[1] = __builtin_amdgcn_mfma_f32_16x16x32_bf16(tr16x2(v1, v1 + 16 * 128), pf, yi[1], 0, 0, 0);
                      yi[2] = __builtin_amdgcn_mfma_f32_16x16x32_bf16(tr16x2(v2, v2 + 16 * 128), pf, yi[2], 0, 0, 0); yi[3] = __builtin_amdgcn_mfma_f32_16x16x32_bf16(tr16x2(v3, v3 + 16 * 128), pf, yi[3], 0, 0, 0); }
                }
            }
#pragma unroll
            for (int ks = 0; ks < 4; ++ks)
#pragma unroll
                for (int u4 = 0; u4 < 4; ++u4) { const bf16x8 sf = *(const LAS bf16x8*)(Scur + oRow + 16 * u4 * RSK + 64 * ks); yi[u4] = __builtin_amdgcn_mfma_f32_16x16x32_bf16(sf, qf[ks], yi[u4], 0, 0, 0); }
#pragma unroll
            for (int ks = 0; ks < 4; ++ks) {
                const LAS unsigned char* ka = Kim + oKt + 32 * ks * 256;
                const bf16x8 kz = tr16x2(ka, ka + 16 * 256);
                const LAS unsigned char* v0 = Vim + oV0 + 32 * ks * 128; const LAS unsigned char* v1 = Vim + oV1 + 32 * ks * 128; const LAS unsigned char* v2 = Vim + oV2 + 32 * ks * 128; const LAS unsigned char* v3 = Vim + oV3 + 32 * ks * 128;
                st[0] = __builtin_amdgcn_mfma_f32_16x16x32_bf16(kz, tr16x2(v0, v0 + 16 * 128), st[0], 0, 0, 0); st[1] = __builtin_amdgcn_mfma_f32_16x16x32_bf16(kz, tr16x2(v1, v1 + 16 * 128), st[1], 0, 0, 0);
                st[2] = __builtin_amdgcn_mfma_f32_16x16x32_bf16(kz, tr16x2(v2, v2 + 16 * 128), st[2], 0, 0, 0); st[3] = __builtin_amdgcn_mfma_f32_16x16x32_bf16(kz, tr16x2(v3, v3 + 16 * 128), st[3], 0, 0, 0);
            }
#pragma unroll
            for (int u4 = 0; u4 < 4; ++u4) { u32x2 sw2; sw2.x = cvt_pk_bf16(st[u4][0], st[u4][1]); sw2.y = cvt_pk_bf16(st[u4][2], st[u4][3]);
                *(LAS u32x2*)(Snxt + oSw + 16 * u4 * RSK) = sw2; }
            float ss = 0.f; u32x2 yw[4];
#pragma unroll
            for (int u4 = 0; u4 < 4; ++u4) { const f32x4 y = yi[u4]; ss += (y[0] * y[0] + y[1] * y[1]) + (y[2] * y[2] + y[3] * y[3]);
                yw[u4].x = cvt_pk_bf16(silu_f(bflo(gr[u4].x)) * y[0], silu_f(bfhi(gr[u4].x)) * y[1]); yw[u4].y = cvt_pk_bf16(silu_f(bflo(gr[u4].y)) * y[2], silu_f(bfhi(gr[u4].y)) * y[3]); }
            ss += __shfl_xor(ss, 16); ss += __shfl_xor(ss, 32);
            asm volatile("s_waitcnt vmcnt(0) lgkmcnt(0)" ::: "memory");
#pragma unroll
            for (int ks = 0; ks < 4; ++ks) qf[ks] = __builtin_bit_cast(bf16x8, qr[ks]);
#pragma unroll
            for (int u4 = 0; u4 < 4; ++u4) gr[u4] = grn[u4];
            asm volatile("" ::: "memory");
#pragma unroll
            for (int u4 = 0; u4 < 4; ++u4) *(u32x2*)((dummy ? (bf16_t*)(p.ws + WS_SCR) + (size_t)(((b * 4 + h) * 4 + s) * SEQ) * 64 : vbase) + (size_t)(n * 128 + 16 * w + fr) * 64 + 16 * u4 + 4 * fg) = yw[u4];
            if (fg == 0) ssq[row * 16 + h * 4 + s] = ss;
        }
#undef RET_ISSUE
    }
    }
    for (int rep3 = 0; rep3 < NREP(14); ++rep3) {
    bf16_t* MX = (bf16_t*)(p.ws + WS_H);
    const int gw = F.bx * NWAVES + F.wave, NGW = F.G * NWAVES;
    const int c = F.lane * 8, grp = F.lane >> 4, win = 2 << grp;
    for (int blk = gw; blk < T / 8; blk += NGW) {
        const int row0 = blk * 8; const int pos0 = row0 & (SEQ - 1);
        u32x4 R[23];
#pragma unroll
        for (int i = 0; i < 23; ++i) R[i] = *(const u32x4*)(P + ((long)(row0 - 15 + i) * 512) + c);
        if (pos0 < 15) {
#pragma unroll
            for (int i = 0; i < 15; ++i) if (pos0 - 15 + i < 0) R[i] = (u32x4){0u, 0u, 0u, 0u}; }
        float acc[8];
#pragma unroll
        for (int k = 0; k < 8; ++k) acc[k] = 0.f;
#pragma clang loop unroll(full)
        for (int j = 0; j < 16; ++j) { u32x4 uv = R[15 - j]; if (!(j < win)) uv = (u32x4){0u, 0u, 0u, 0u};
            acc[0] += bflo(uv.x); acc[1] += bfhi(uv.x); acc[2] += bflo(uv.y); acc[3] += bfhi(uv.y); acc[4] += bflo(uv.z); acc[5] += bfhi(uv.z); acc[6] += bflo(uv.w); acc[7] += bfhi(uv.w); }
#pragma clang loop unroll(full)
        for (int r = 0; r < 8; ++r) {
            const int pos = pos0 + r; const int cnt = (pos + 1) < win ? (pos + 1) : win;
            if (r > 0) { const u32x4 nv = R[15 + r]; const u32x4 o2 = R[13 + r], o4 = R[11 + r], o8 = R[7 + r], o16 = R[r - 1 < 0 ? 0 : r - 1];
                u32x4 ov = grp == 0 ? o2 : (grp == 1 ? o4 : (grp == 2 ? o8 : o16));
                acc[0] += bflo(nv.x) - bflo(ov.x); acc[1] += bfhi(nv.x) - bfhi(ov.x); acc[2] += bflo(nv.y) - bflo(ov.y); acc[3] += bfhi(nv.y) - bfhi(ov.y);
                acc[4] += bflo(nv.z) - bflo(ov.z); acc[5] += bfhi(nv.z) - bfhi(ov.z); acc[6] += bflo(nv.w) - bflo(ov.w); acc[7] += bfhi(nv.w) - bfhi(ov.w); }
            const u32x4 cu = R[15 + r]; const float inv = 1.0f / (float)cnt;
            u32x4 wv; wv.x = cvt_pk_bf16(acc[0] * inv - bflo(cu.x), acc[1] * inv - bfhi(cu.x)); wv.y = cvt_pk_bf16(acc[2] * inv - bflo(cu.y), acc[3] * inv - bfhi(cu.y));
            wv.z = cvt_pk_bf16(acc[4] * inv - bflo(cu.z), acc[5] * inv - bfhi(cu.z)); wv.w = cvt_pk_bf16(acc[6] * inv - bflo(cu.w), acc[7] * inv - bfhi(cu.w));
            *(u32x4*)(MX + (size_t)(row0 + r) * 512 + c) = wv;
        }
    }
    }
}

__device__ __forceinline__ void phase_norm2_route(const Params& p, const Ctx& F, int l, bool dummy = false) {
    LAS float* wr = (LAS float*)F.lds;
    LAS int* se = (LAS int*)(F.lds + 81920);
    LAS float* swl = (LAS float*)(F.lds + 81920 + 1024);
    LAS int* spos = (LAS int*)(F.lds + 81920 + 2048);
    LAS int* lcnt = (LAS int*)(F.lds + 81920 + 3072);
    LAS int* lbase = (LAS int*)(F.lds + 81920 + 3072 + 64);
    LAS float* lgt = (LAS float*)(F.lds + 81920 + 4096) + F.wave * 256;
    LAS float* avl = (LAS float*)(F.lds + 94208);
    LAS float* cvl = (LAS float*)(F.lds + 98304);
    for (int i = F.tid; i < D * NE; i += NTHR) wr[(i >> 4) * 20 + (i & 15)] = p.w_router[i];
    const float* mod = (const float*)(p.ws + WS_MOD);
    bf16_t* H = (bf16_t*)(p.ws + WS_H);
    unsigned* counts = (unsigned*)(p.ws + WS_CTL) + CW_CNT + l * 64 + (dummy ? 16 : 0);
    int* stok = (int*)(p.ws + (dummy ? WS_SCR : WS_STOK)); float* sw = (float*)(p.ws + (dummy ? WS_SCR + 4 * MiB : WS_SW));
    const int lane = F.lane;
    const bool b5 = (lane & 32) != 0, b4 = (lane & 16) != 0, b3 = (lane & 8) != 0, b2 = (lane & 4) != 0;
    for (int pass = F.bx; pass < T / 128; pass += F.G) {
        __syncthreads();
        if (F.tid < 16) lcnt[F.tid] = 0;
        const int row0 = pass * 128 + F.wave * 16, b = row0 / SEQ;
        const float* m1 = mod + (size_t)(l * NB + b) * 6144;
        for (int d = F.tid; d < D; d += NTHR) { avl[d] = p.n2g[l * D + d] * (m1[4096 + d] + 1.0f); cvl[d] = m1[3072 + d]; }
        const bf16_t* XB = (const bf16_t*)(p.ws + WS_XB);
        constexpr int TG = 4;
        unsigned nx[TG][8];
#pragma unroll
        for (int tk = 0; tk < TG; ++tk)
#pragma unroll
            for (int i = 0; i < 8; ++i) nx[tk][i] = *(const unsigned*)(XB + (size_t)(row0 + tk) * D + i * 128 + 2 * lane);
        __syncthreads();
        for (int r0 = 0; r0 < 16; r0 += TG) {
            int ln = lane; asm volatile("" : "+v"(ln));
            unsigned cur[TG][8]; float rstd[TG];
#pragma unroll
            for (int tk = 0; tk < TG; ++tk) { float ss = 0.f;
#pragma unroll
                for (int i = 0; i < 8; ++i) { cur[tk][i] = nx[tk][i]; const float a0 = bflo(cur[tk][i]), a1 = bfhi(cur[tk][i]); ss += a0 * a0 + a1 * a1; }
                rstd[tk] = rsqrtf(wave_sum(ss) * (1.0f / D) + EPS); }
            if (r0 + TG < 16) {
#pragma unroll
                for (int tk = 0; tk < TG; ++tk)
#pragma unroll
                    for (int i = 0; i < 8; ++i) nx[tk][i] = *(const unsigned*)(XB + (size_t)(row0 + r0 + TG + tk) * D + i * 128 + 2 * ln); }
            f32x2 lg2[TG][8];
#pragma unroll
            for (int tk = 0; tk < TG; ++tk)
#pragma unroll
                for (int j = 0; j < 8; ++j) lg2[tk][j] = (f32x2){0.f, 0.f};
#pragma unroll
            for (int i = 0; i < 8; ++i) {
                f32x2 hv[TG]; const f32x2 avi = *(const LAS f32x2*)(avl + i * 128 + 2 * ln), cvi = *(const LAS f32x2*)(cvl + i * 128 + 2 * ln);
#pragma unroll
                for (int tk = 0; tk < TG; ++tk) { const f32x2 v = (f32x2){bflo(cur[tk][i]), bfhi(cur[tk][i])}; hv[tk] = v * rstd[tk] * avi + cvi;
                    *(unsigned*)(H + (size_t)(row0 + r0 + tk) * D + i * 128 + 2 * ln) = cvt_pk_bf16(hv[tk][0], hv[tk][1]); }
                const LAS f32x4* wp = (const LAS f32x4*)(wr + (i * 128 + 2 * ln) * 20);
#pragma unroll
                for (int q = 0; q < 2; ++q) { const f32x4 w0 = wp[5 * q], w1 = wp[5 * q + 1], w2 = wp[5 * q + 2], w3 = wp[5 * q + 3];
                    const f32x2 wv[8] = {{w0[0], w0[1]}, {w0[2], w0[3]}, {w1[0], w1[1]}, {w1[2], w1[3]}, {w2[0], w2[1]}, {w2[2], w2[3]}, {w3[0], w3[1]}, {w3[2], w3[3]}};
#pragma unroll
                    for (int tk = 0; tk < TG; ++tk) { const float hh = hv[tk][q]; const f32x2 h2 = (f32x2){hh, hh};
#pragma unroll
                        for (int j = 0; j < 8; ++j) lg2[tk][j] = __builtin_elementwise_fma(h2, wv[j], lg2[tk][j]); }
#pragma unroll
                    for (int tk = 0; tk < TG; ++tk) asm volatile("" : "+v"(lg2[tk][0]), "+v"(lg2[tk][1]), "+v"(lg2[tk][2]), "+v"(lg2[tk][3]), "+v"(lg2[tk][4]), "+v"(lg2[tk][5]), "+v"(lg2[tk][6]), "+v"(lg2[tk][7]) :: "memory"); }
            }
#pragma unroll
            for (int tk = 0; tk < TG; ++tk) {
                float lg[NE];
#pragma unroll
                for (int e = 0; e < NE; ++e) lg[e] = lg2[tk][e >> 1][e & 1];
                float k8[8], k4[4], k2[2];
#pragma unroll
                for (int i = 0; i < 8; ++i) { const float snd = b5 ? lg[i] : lg[i + 8]; k8[i] = (b5 ? lg[i + 8] : lg[i]) + __shfl_xor(snd, 32); }
#pragma unroll
                for (int i = 0; i < 4; ++i) { const float snd = b4 ? k8[i] : k8[i + 4]; k4[i] = (b4 ? k8[i + 4] : k8[i]) + __shfl_xor(snd, 16); }
#pragma unroll
                for (int i = 0; i < 2; ++i) { const float snd = b3 ? k4[i] : k4[i + 2]; k2[i] = (b3 ? k4[i + 2] : k4[i]) + __shfl_xor(snd, 8); }
                float k1; { const float snd = b2 ? k2[0] : k2[1]; k1 = (b2 ? k2[1] : k2[0]) + __shfl_xor(snd, 4); }
                k1 += __shfl_xor(k1, 1); k1 += __shfl_xor(k1, 2);
                if ((ln & 3) == 0) lgt[(r0 + tk) * 16 + (ln >> 2)] = k1;
            }
        }
        {
            const int t = lane & 15;
            float pr[NE]; float mx = -3.0e38f;
#pragma unroll
            for (int q = 0; q < 4; ++q) { const f32x4 x4 = *(const LAS f32x4*)(lgt + t * 16 + 4 * q); const f32x4 b4v = *(const f32x4*)(p.b_router + 4 * q);
                pr[4 * q] = x4[0] + b4v[0]; pr[4 * q + 1] = x4[1] + b4v[1]; pr[4 * q + 2] = x4[2] + b4v[2]; pr[4 * q + 3] = x4[3] + b4v[3]; }
#pragma unroll
            for (int e = 0; e < NE; ++e) mx = fmaxf(mx, pr[e]);
            float den = 0.f;
#pragma unroll
            for (int e = 0; e < NE; ++e) { pr[e] = __expf(pr[e] - mx); den += pr[e]; }
            const float rden = 1.0f / den;
#pragma unroll
            for (int e = 0; e < NE; ++e) pr[e] *= rden;
            float best = -1.0f; int sg = 0; float c0 = 0.f, c1 = 0.f, c2 = 0.f, c3 = 0.f;
#pragma unroll
            for (int g = 0; g < 4; ++g) { const float a0 = pr[4 * g], a1 = pr[4 * g + 1], a2 = pr[4 * g + 2], a3 = pr[4 * g + 3];
                const float hi01 = fmaxf(a0, a1), lo01 = fminf(a0, a1), hi23 = fmaxf(a2, a3), lo23 = fminf(a2, a3);
                const float m1v = fmaxf(hi01, hi23); const float m2v = fmaxf(fminf(hi01, hi23), fmaxf(lo01, lo23));
                const float gs = m1v + m2v;
                if (gs > best) { best = gs; sg = g; c0 = a0; c1 = a1; c2 = a2; c3 = a3; } }
            int i0 = 0; float p0 = c0;
            if (c1 > p0) { p0 = c1; i0 = 1; } if (c2 > p0) { p0 = c2; i0 = 2; } if (c3 > p0) { p0 = c3; i0 = 3; }
            int i1 = -1; float p1 = -1.0f;
            if (i0 != 0 && c0 > p1) { p1 = c0; i1 = 0; } if (i0 != 1 && c1 > p1) { p1 = c1; i1 = 1; } if (i0 != 2 && c2 > p1) { p1 = c2; i1 = 2; } if (i0 != 3 && c3 > p1) { p1 = c3; i1 = 3; }
            const float wsum = p0 + p1;
            if (lane < 16) { const int sl = (F.wave * 16 + t) * 2; se[sl] = sg * 4 + i0; se[sl + 1] = sg * 4 + i1; swl[sl] = p0 / wsum; swl[sl + 1] = p1 / wsum; }
        }
        __syncthreads();
        if (F.tid < 256) spos[F.tid] = atomicAdd((int*)&lcnt[se[F.tid]], 1);
        __syncthreads();
        if (F.tid < 16) lbase[F.tid] = (int)__hip_atomic_fetch_add(counts + F.tid, (unsigned)lcnt[F.tid], __ATOMIC_RELAXED, __HIP_MEMORY_SCOPE_AGENT);
        __syncthreads();
        if (F.tid < 256) { const int e = se[F.tid]; const int pos = lbase[e] + spos[F.tid]; const int tok = pass * 128 + (F.tid >> 1);
            stok[(size_t)e * CAP + pos] = tok * 2 + (F.tid & 1); sw[(size_t)e * CAP + pos] = swl[F.tid]; }
    }
    __syncthreads();
}

__device__ __forceinline__ void phase_final(const Params& p, const Ctx& F) {
    const float* mod = (const float*)(p.ws + WS_MOD);
    const bf16_t* ybuf = (const bf16_t*)(p.ws + WS_YBUF);
    const int gw = F.bx * NWAVES + F.wave, NGW = F.G * NWAVES;
    for (int blk = gw; blk < T / 16; blk += NGW) {
        const int row0 = blk * 16, b = row0 / SEQ;
        f32x4 gv[4], g2v[4];
#pragma unroll
        for (int i = 0; i < 4; ++i) { const int d = i * 256 + F.lane * 4; gv[i] = *(const f32x4*)(p.final_g + d); g2v[i] = *(const f32x4*)(mod + (size_t)((DEPTH - 1) * NB + b) * 6144 + 5120 + d); }
        const bf16_t* XB = (const bf16_t*)(p.ws + WS_XB);
        u32x2 nxb[4], ny0[4], ny1[4];
#pragma unroll
        for (int i = 0; i < 4; ++i) { const int d = i * 256 + F.lane * 4; const size_t row = (size_t)row0;
            nxb[i] = *(const u32x2*)(XB + row * D + d); ny0[i] = *(const u32x2*)(ybuf + (2 * row) * D + d); ny1[i] = *(const u32x2*)(ybuf + (2 * row + 1) * D + d); }
        for (int r = 0; r < 16; ++r) {
            const size_t row = (size_t)(row0 + r);
            f32x4 v[4]; u32x2 y0[4], y1[4]; float ss = 0.f;
#pragma unroll
            for (int i = 0; i < 4; ++i) { v[i] = (f32x4){bflo(nxb[i].x), bfhi(nxb[i].x), bflo(nxb[i].y), bfhi(nxb[i].y)}; y0[i] = ny0[i]; y1[i] = ny1[i]; }
            if (r + 1 < 16) {
#pragma unroll
                for (int i = 0; i < 4; ++i) { const int d = i * 256 + F.lane * 4; const size_t rn = row + 1;
                    nxb[i] = *(const u32x2*)(XB + rn * D + d); ny0[i] = *(const u32x2*)(ybuf + (2 * rn) * D + d); ny1[i] = *(const u32x2*)(ybuf + (2 * rn + 1) * D + d); } }
#pragma unroll
            for (int i = 0; i < 4; ++i) {
                f32x4 ys; ys[0] = bflo(y0[i].x) + bflo(y1[i].x); ys[1] = bfhi(y0[i].x) + bfhi(y1[i].x); ys[2] = bflo(y0[i].y) + bflo(y1[i].y); ys[3] = bfhi(y0[i].y) + bfhi(y1[i].y);
                v[i] = v[i] + g2v[i] * ys;
                ss += (v[i][0] * v[i][0] + v[i][1] * v[i][1]) + (v[i][2] * v[i][2] + v[i][3] * v[i][3]); }
            const float rstd = rsqrtf(wave_sum(ss) * (1.0f / D) + EPS);
#pragma unroll
            for (int i = 0; i < 4; ++i) { const int d = i * 256 + F.lane * 4; *(f32x4*)(p.out + row * D + d) = v[i] * rstd * gv[i]; }
        }
    }
}

constexpr int PH_PER_LAYER = 9, PH_TOTAL = 2 + DEPTH * PH_PER_LAYER;

__device__ __forceinline__ Params fresh_params() {
    Params r{};
#if defined(__HIP_DEVICE_COMPILE__)
    typedef const Params __attribute__((address_space(4))) KParams;
    KParams* q = (KParams*)__builtin_amdgcn_kernarg_segment_ptr(); asm volatile("" : "+s"(q));
    r.x = q->x; r.c = q->c; r.w_ada = q->w_ada; r.b_ada = q->b_ada; r.n1g = q->n1g; r.n2g = q->n2g; r.w_in = q->w_in; r.w_ret_o = q->w_ret_o; r.pool_w = q->pool_w; r.pool_scale = q->pool_scale;
    r.w_pool_o = q->w_pool_o; r.w_out = q->w_out; r.w_router = q->w_router; r.b_router = q->b_router; r.w_eg = q->w_eg; r.w_eu = q->w_eu; r.w_ed = q->w_ed; r.final_g = q->final_g;
    r.out = q->out; r.ws = q->ws; r.ph_lo = q->ph_lo; r.ph_hi = q->ph_hi;
#endif
    return r;
}
__global__ void __launch_bounds__(NTHR, 2) fwd_kernel(Params p0) {
    extern __shared__ __attribute__((aligned(16))) unsigned char lds_raw[];
    LAS unsigned char* const lds = (LAS unsigned char*)lds_raw;
    volatile LAS unsigned* bst = (volatile LAS unsigned*)(lds + LDS_BARW);
    if (threadIdx.x == 0) { bst[0] = 0u; bst[1] = 0u; bst[2] = 0u; bst[3] = 0u; }
    __syncthreads();
    XcdBarrier bar = xcd_barrier_post((unsigned*)(p0.ws + WS_CTL), bst);
    const int lo = p0.ph_lo, hi = p0.ph_hi;
#ifndef PHMASK
#define PHMASK 0xFFF
#endif
#define PSEL(j) ((PHMASK >> (j)) & 1)
#define IN(k) (lo <= (k) && (k) < hi)
#define SEAM(k) do { if (IN(k) && IN((k) + 1)) xcd_barrier(bar); } while (0)
#define PHASE_CTX() const Params p = fresh_params(); const Ctx F = make_ctx(lds); unsigned char* ws = p.ws; bf16_t* H = (bf16_t*)(ws + WS_H); \
    const int vcu = (F.G % 8 == 0) ? (F.bx % 8) * (F.G / 8) + F.bx / 8 : F.bx; (void)H; (void)vcu; (void)ws

    if (PSEL(10) && IN(0)) { PHASE_CTX(); phase_prologue(p, F); }
    SEAM(0);
    for (int l = 0; l < DEPTH; ++l) {
        const int pb = 1 + l * PH_PER_LAYER;
        if (PSEL(0) && IN(pb + 0)) { PHASE_CTX(); phase_norm1(p, F, l, NREP(12)); }
        SEAM(pb + 0);
        if (PSEL(1) && IN(pb + 1)) for (int rep = 0; rep < NREP(1); ++rep) { PHASE_CTX(); pg8::DenseOrder S; S.init(T, INW, F.G, F.bx, H, D, (const bf16_t*)(ws + WT_IN), D); S.wgm = 2;
            pg8::EpiProj E{ws, (const float*)(ws + WS_ROPE), (const float*)(ws + WS_ROPE) + SEQ * 64, (const float*)(ws + WS_DEC)};
            pg8::gemm_phase<pg8::EpiProj, pg8::DenseOrder>(F.lds, S, E, D, D, D); }
        SEAM(pb + 1);
        #ifdef USE_RET2
        if (PSEL(2) && IN(pb + 2)) { PHASE_CTX(); phase_ret2(p, F, vcu); }
#else
        if (PSEL(2) && IN(pb + 2)) { PHASE_CTX(); phase_ret3(p, F, vcu); }
#endif
        SEAM(pb + 2);
#ifdef USE_SUBUNITS
        if (PSEL(3) && IN(pb + 3)) for (int rep = 0; rep < NREP(3); ++rep) { PHASE_CTX(); pg8::HeadOrder S; S.d.init(T, D, F.G, F.bx, (const bf16_t*)(ws + WS_VB), 64, (const bf16_t*)(ws + WT_RO), D);
            pg8::EpiRet E{(const float*)(ws + WS_SSQ), ws + WS_GATE, (bf16_t*)(ws + WS_M1)};
            { pg8::DUnit tu; for (int i = 0; i < pg8::RTAB_MAXU && S.d.next(i, tu); ++i) E.fill_table(tu, i, F.tid, F.lds); __syncthreads(); }
            pg8::gemm_phase<pg8::EpiRet, pg8::HeadOrder>(F.lds, S, E, 256, 64, D, (size_t)SEQ * 64 * 2); }
#else
        if (PSEL(3) && IN(pb + 3)) for (int rep = 0; rep < NREP(3); ++rep) { PHASE_CTX(); pg8::RetOrder S; S.d.init(T, D, F.G, F.bx, (const bf16_t*)(ws + WS_VB), 64, (const bf16_t*)(ws + WT_RO), D);
            pg8::EpiRetK E{(const float*)(ws + WS_SSQ), ws + WS_GATE, (bf16_t*)(ws + WS_M1)};
            { pg8::DUnit tu; for (int i = 0; i < pg8::RTAB_MAXU && S.next(i, tu); ++i) E.fill_table(tu, i, F.tid, F.lds); __syncthreads(); }
            pg8::gemm_phase<pg8::EpiRetK, pg8::RetOrder>(F.lds, S, E, D, 64, D, (size_t)SEQ * 64 * 2); }
#endif
        { asm volatile("s_waitcnt vmcnt(0)" ::: "memory"); __syncthreads(); }
        if (PSEL(4) && IN(pb + 4)) for (int rep = 0; rep < NREP(4); ++rep) { PHASE_CTX(); pg8::DenseOrder S; S.init(T, D, F.G, F.bx, H, 512, (const bf16_t*)(ws + WT_PE), 512);
            pg8::EpiGate<true> E{ws + WS_GATE, 4, (const bf16_t*)(ws + WS_M1), D, (bf16_t*)(ws + WS_MRG), D};
            pg8::gemm_phase<pg8::EpiGate<true>, pg8::DenseOrder>(F.lds, S, E, 512, 512, 512); }
        SEAM(pb + 4);
        if (PSEL(5) && IN(pb + 5)) for (int rep = 0; rep < NREP(5); ++rep) { PHASE_CTX(); pg8::DenseOrder S; S.init(T, D, F.G, F.bx, (const bf16_t*)(ws + WS_MRG), D, (const bf16_t*)(ws + WT_OUT), D);
            if (l == 0) { pg8::EpiResid<true> E{p.x, nullptr, (bf16_t*)(ws + (rep + 1 < NREP(5) ? WS_SCR : WS_XB)), (const float*)(ws + WS_MOD) + 2048};
                pg8::gemm_phase<pg8::EpiResid<true>, pg8::DenseOrder>(F.lds, S, E, D, D, D); }
            else { pg8::EpiResid<false> E{nullptr, (const bf16_t*)(ws + WS_XB), (bf16_t*)(ws + (rep + 1 < NREP(5) ? WS_SCR : WS_XB)), (const float*)(ws + WS_MOD) + (size_t)l * NB * 6144 + 2048};
                pg8::gemm_phase<pg8::EpiResid<false>, pg8::DenseOrder>(F.lds, S, E, D, D, D); } }
        SEAM(pb + 5);
        if (PSEL(6) && IN(pb + 6)) for (int rep = 0; rep < NREP(6); ++rep) { PHASE_CTX(); phase_norm2_route(p, F, l, rep + 1 < NREP(6)); }
        SEAM(pb + 6);
        if (PSEL(7) && IN(pb + 7)) for (int rep = 0; rep < NREP(7); ++rep) {
            PHASE_CTX();
            LAS int* lc = (LAS int*)(F.lds + LDS_CNT);
            if (F.tid < 16) lc[F.tid] = (int)__hip_atomic_load((unsigned*)(ws + WS_CTL) + CW_CNT + l * 64 + F.tid, __ATOMIC_RELAXED, __HIP_MEMORY_SCOPE_AGENT);
            __syncthreads();
            pg8::MoeOrder<true> S; S.cnts = lc; S.G = F.G; S.c = vcu; S.A = (const char*)H; S.Bt = (const char*)(ws + WT_GU); S.atile = 0; S.bexp = (size_t)1024 * D * 2; S.btile = (size_t)256 * D * 2;
            S.stok = (const int*)(ws + WS_STOK); S.lda = D;
            pg8::EpiGateUp E{(bf16_t*)(ws + WS_ACT)};
            pg8::gemm_phase<pg8::EpiGateUp, pg8::MoeOrder<true>>(F.lds, S, E, D, D, D);
        }
        SEAM(pb + 7);
        if (PSEL(8) && IN(pb + 8)) for (int rep = 0; rep < NREP(8); ++rep) {
            PHASE_CTX();
            LAS int* lc = (LAS int*)(F.lds + LDS_CNT);
            if (F.tid < 16) lc[F.tid] = (int)__hip_atomic_load((unsigned*)(ws + WS_CTL) + CW_CNT + l * 64 + F.tid, __ATOMIC_RELAXED, __HIP_MEMORY_SCOPE_AGENT);
            __syncthreads();
            pg8::MoeOrder<false> S; S.cnts = lc; S.G = F.G; S.c = vcu; S.A = (const char*)(ws + WS_ACT); S.Bt = (const char*)(ws + WT_DN); S.atile = (size_t)256 * DE * 2; S.bexp = (size_t)D * DE * 2; S.btile = (size_t)256 * DE * 2;
            S.stok = (const int*)(ws + WS_STOK); S.lda = DE;
            pg8::EpiDown E{(bf16_t*)(ws + WS_YBUF), (const int*)(ws + WS_STOK), (const float*)(ws + WS_SW)};
            pg8::gemm_phase<pg8::EpiDown, pg8::MoeOrder<false>>(F.lds, S, E, DE, DE, DE);
        }
        SEAM(pb + 8);
    }
    if (PSEL(11) && IN(PH_TOTAL - 1)) { PHASE_CTX(); phase_final(p, F); }
#undef IN
#undef SEAM
}

extern "C" void kernel_launch(void* const* d_in, const int* in_sizes, int n_in, void* d_out, int out_size, void* d_ws, size_t ws_size, hipStream_t stream) {
    static int grid = 0;
    if (grid == 0) {
        if (n_in != 18 || in_sizes[0] != T * D || out_size != T * D || ws_size < WS_END) { fprintf(stderr, "kernel_launch: unexpected shapes / workspace (n_in %d, ws %zu)\n", n_in, ws_size); grid = -1; return; }
        int dev = 0, cus = 0, per_cu = 0;
        if (hipGetDevice(&dev) != hipSuccess || hipDeviceGetAttribute(&cus, hipDeviceAttributeMultiprocessorCount, dev) != hipSuccess) { grid = -1; return; }
        if (hipFuncSetAttribute((const void*)fwd_kernel, hipFuncAttributeMaxDynamicSharedMemorySize, LDS_BYTES) != hipSuccess) { fprintf(stderr, "kernel_launch: hipFuncSetAttribute failed\n"); grid = -1; return; }
        if (hipOccupancyMaxActiveBlocksPerMultiprocessor(&per_cu, (const void*)fwd_kernel, NTHR, LDS_BYTES) != hipSuccess || per_cu < 1) { fprintf(stderr, "kernel_launch: occupancy query says %d\n", per_cu); }
        (void)hipGetLastError();
        grid = cus;
    }
    if (grid < 0) return;
    if (hipMemsetAsync((char*)d_ws + WS_CTL, 0, CTL_ZERO_BYTES, stream) != hipSuccess) return;
    Params p{};
    p.x = (const float*)d_in[0]; p.c = (const float*)d_in[1]; p.w_ada = (const float*)d_in[2]; p.b_ada = (const float*)d_in[3]; p.n1g = (const float*)d_in[4]; p.n2g = (const float*)d_in[5];
    p.w_in = (const float*)d_in[6]; p.w_ret_o = (const float*)d_in[7]; p.pool_w = (const float*)d_in[8]; p.pool_scale = (const float*)d_in[9]; p.w_pool_o = (const float*)d_in[10]; p.w_out = (const float*)d_in[11];
    p.w_router = (const float*)d_in[12]; p.b_router = (const float*)d_in[13]; p.w_eg = (const float*)d_in[14]; p.w_eu = (const float*)d_in[15]; p.w_ed = (const float*)d_in[16]; p.final_g = (const float*)d_in[17];
    p.out = (float*)d_out; p.ws = (unsigned char*)d_ws; p.ph_lo = 0; p.ph_hi = PH_TOTAL;
    hipLaunchKernelGGL(fwd_kernel, dim3(grid), dim3(NTHR), LDS_BYTES, stream, p);
}
```

```cpp
#include <hip/hip_runtime.h>
#include <cstdio>
#include <cstdint>

#define LAS __attribute__((address_space(3)))
#ifndef REPMASK
#define REPMASK 0x000
#endif
#define NREP(j) (1 + ((REPMASK >> (j)) & 1))
typedef unsigned short bf16_t;
typedef short bf16x8 __attribute__((ext_vector_type(8)));
typedef float f32x4 __attribute__((ext_vector_type(4)));
typedef float f32x2 __attribute__((ext_vector_type(2)));
typedef unsigned u32x4 __attribute__((ext_vector_type(4)));
typedef unsigned u32x2 __attribute__((ext_vector_type(2)));

constexpr int NB = 16, SEQ = 2048, T = NB * SEQ, D = 1024, DEPTH = 4;
constexpr int INW = 5632, CQ = 0, CK = 512, CV = 1024, CG = 2048, CU = 3072, CAR = 3584, CAPL = 4608;
constexpr int NE = 16, DE = 512, CAP = 32768;
constexpr float EPS = 1e-6f;
constexpr int NWAVES = 8, NTHR = 512;

constexpr size_t MiB = 1u << 20;
constexpr size_t WS_CTL = 0, CTL_ZERO_BYTES = 65536;
constexpr size_t WS_MOD = 1 * MiB;
constexpr size_t WS_ROPE = 3 * MiB;
constexpr size_t WS_DEC = 2 * MiB + 512 * 1024;
constexpr size_t WS_STOK = 4 * MiB;
constexpr size_t WS_SW = 6 * MiB;
constexpr size_t WS_SSQ = 8 * MiB;
constexpr size_t WS_WL = 16 * MiB;
constexpr size_t WT_IN = WS_WL, WT_RO = WS_WL + 11 * MiB, WT_PE = WS_WL + 13 * MiB, WT_OUT = WS_WL + 14 * MiB, WT_GU = WS_WL + 16 * MiB, WT_DN = WS_WL + 48 * MiB;
constexpr size_t WS_H = 80 * MiB;
constexpr size_t WS_PROJ = 144 * MiB;
constexpr size_t WS_U = WS_PROJ;
constexpr size_t WS_M1 = WS_PROJ + 32 * MiB;
constexpr size_t WS_MRG = WS_PROJ + 96 * MiB;
constexpr size_t WS_ACT = WS_PROJ;
constexpr size_t WS_YBUF = WS_PROJ + 72 * MiB;
constexpr size_t WS_QB = 344 * MiB;
constexpr size_t WS_KB = 376 * MiB;
constexpr size_t WS_VB = 408 * MiB;
constexpr size_t WS_GB = 472 * MiB;
constexpr size_t WS_XB = 536 * MiB;
constexpr size_t WS_GATE = 600 * MiB;
constexpr size_t WS_SCR = WS_M1;
constexpr size_t WS_END = 664 * MiB;
constexpr int CW_CNT = 4096;

constexpr int LDS_BYTES = 163840;
constexpr int LDS_CNT = 131072 + 256;
constexpr int LDS_BARW = LDS_BYTES - 64;

__device__ __forceinline__ int rfl(int v) { return __builtin_amdgcn_readfirstlane(v); }
typedef __bf16 bf16x2_t __attribute__((ext_vector_type(2)));
__device__ __forceinline__ unsigned cvt_pk_bf16(float lo, float hi) { const f32x2 f = {lo, hi}; return __builtin_bit_cast(unsigned, __builtin_convertvector(f, bf16x2_t)); }
__device__ __forceinline__ bf16_t f2bf(float f) { return (bf16_t)(cvt_pk_bf16(f, 0.f) & 0xffffu); }
__device__ __forceinline__ float bf2f(bf16_t b) { return __uint_as_float(((unsigned)b) << 16); }
__device__ __forceinline__ float bflo(unsigned w) { return __uint_as_float(w << 16); }
__device__ __forceinline__ float bfhi(unsigned w) { return __uint_as_float(w & 0xffff0000u); }
__device__ __forceinline__ float wave_sum(float v) {
#pragma unroll
    for (int o = 1; o < 64; o <<= 1) v += __shfl_xor(v, o);
    return v;
}
__device__ __forceinline__ void unpack_u8x8(const u32x2 w, float (&o)[8]) {
    o[0] = (float)(w.x & 255u) * (1.0f / 255.0f); o[1] = (float)((w.x >> 8) & 255u) * (1.0f / 255.0f); o[2] = (float)((w.x >> 16) & 255u) * (1.0f / 255.0f); o[3] = (float)(w.x >> 24) * (1.0f / 255.0f);
    o[4] = (float)(w.y & 255u) * (1.0f / 255.0f); o[5] = (float)((w.y >> 8) & 255u) * (1.0f / 255.0f); o[6] = (float)((w.y >> 16) & 255u) * (1.0f / 255.0f); o[7] = (float)(w.y >> 24) * (1.0f / 255.0f);
}
__device__ __forceinline__ float sigmoid_f(float x) { return __builtin_amdgcn_rcpf(1.0f + __expf(-x)); }
__device__ __forceinline__ float silu_f(float x) { return x * sigmoid_f(x); }

#define XB_TMO      128
#define XB_XCNT(j)  (256  + 64 * (j))
#define XB_XSUB(j)  (1280 + 64 * (j))
#define XB_XGEN(j)  (2304 + 64 * (j))
#define XB_TOP      3328
#define XB_TOPGEN   3392
#define XCD_BAR_WORDS 3456
#define XB_SPIN_CAP (1u << 21)

__device__ __forceinline__ unsigned xb_ld(unsigned* p)              { return __hip_atomic_load(p, __ATOMIC_RELAXED, __HIP_MEMORY_SCOPE_AGENT); }
__device__ __forceinline__ unsigned xb_add(unsigned* p, unsigned v) { return __hip_atomic_fetch_add(p, v, __ATOMIC_RELAXED, __HIP_MEMORY_SCOPE_AGENT); }
__device__ __forceinline__ unsigned xb_xcc_id() { return (unsigned)__builtin_amdgcn_s_getreg((3 << 11) | 20) & 0xFu; }
#define XB_SPIN(cond, bar) do { unsigned _sp = 0; while (cond) { __builtin_amdgcn_s_sleep(1); \
    if ((++_sp & 255u) == 0u) { if (xb_ld(&(bar)[XB_TMO])) break; if (_sp > XB_SPIN_CAP) { atomicAdd(&(bar)[XB_TMO], 1u); break; } } } } while (0)

struct XcdBarrier { unsigned* bar; unsigned x; volatile LAS unsigned* st; };

__device__ __forceinline__ XcdBarrier xcd_barrier_post(unsigned* bar, volatile LAS unsigned* st) {
    XcdBarrier b; b.bar = bar; b.x = xb_xcc_id(); b.st = st;
    if (threadIdx.x == 0) (void)xb_add(&bar[XB_XCNT(b.x)], 1u);
    return b;
}
__device__ __forceinline__ void xcd_barrier_complete(unsigned* bar, unsigned x, unsigned& nloc, unsigned& nx) {
    const unsigned G = gridDim.x * gridDim.y * gridDim.z;
    unsigned sum, cnt, mine, sp = 0u;
    for (;;) {
        sum = 0u; cnt = 0u; mine = 0u;
#pragma unroll
        for (unsigned j = 0; j < 16; ++j) { const unsigned c = xb_ld(&bar[XB_XCNT(j)]); sum += c; cnt += (c > 0u) ? 1u : 0u; mine = (j == x) ? c : mine; }
        if (sum == G) break;
        __builtin_amdgcn_s_sleep(1);
        if ((++sp & 255u) == 0u) { if (xb_ld(&bar[XB_TMO])) break; if (sp > XB_SPIN_CAP) { atomicAdd(&bar[XB_TMO], 1u); break; } }
    }
    nloc = mine > 0u ? mine : 1u; nx = cnt > 0u ? cnt : 1u;
}
__device__ __forceinline__ void xcd_barrier(const XcdBarrier& b) {
    asm volatile("s_waitcnt vmcnt(0)" ::: "memory");
    __syncthreads();
    if (threadIdx.x == 0) {
        unsigned* bar = b.bar;
        __builtin_amdgcn_s_waitcnt(0);
        unsigned nloc = b.st[0], nx = b.st[1];
        if (nloc == 0u) { xcd_barrier_complete(bar, b.x, nloc, nx); b.st[0] = nloc; b.st[1] = nx; }
        const unsigned old = xb_add(&bar[XB_XSUB(b.x)], 1u);
        const unsigned gen = old / nloc;
        if (old + 1u == (gen + 1u) * nloc) {
            __builtin_amdgcn_fence(__ATOMIC_RELEASE, "agent");
            asm volatile("s_waitcnt vmcnt(0)" ::: "memory");
            const unsigned og = xb_add(&bar[XB_TOP], 1u);
            const unsigned tg = og / nx;
            if (og + 1u == (tg + 1u) * nx) xb_add(&bar[XB_TOPGEN], 1u);
            else XB_SPIN(xb_ld(&bar[XB_TOPGEN]) == tg, bar);
            __builtin_amdgcn_fence(__ATOMIC_ACQUIRE, "agent");
            xb_add(&bar[XB_XGEN(b.x)], 1u);
            asm volatile("s_waitcnt vmcnt(0)" ::: "memory");
        } else {
            XB_SPIN(xb_ld(&bar[XB_XGEN(b.x)]) == gen, bar);
            __builtin_amdgcn_fence(__ATOMIC_ACQUIRE, "agent");
            asm volatile("s_waitcnt vmcnt(0)" ::: "memory");
        }
    }
    __syncthreads();
}

__device__ __forceinline__ size_t gate_off(int pm, int gt, int ai, int m, int bj, int tid) { return ((size_t)((pm * 8 + gt) * 16 + (ai * 4 + m) * 2 + bj) * 512 + tid) * 8; }
__device__ __forceinline__ size_t m1_off(int pm, int pn, int ai, int m, int bj, int tid) { return ((size_t)((pm * 4 + pn) * 16 + (ai * 4 + m) * 2 + bj) * 512 + tid) * 16; }
namespace pg8 {
constexpr int BM = 256, BK = 64, HALF = 128, HTB = HALF * BK * 2, STAGE_BYTES = 8 * HTB, NXCD = 8, WGM = 8;
__host__ __device__ __forceinline__ int lds_byte(int r, int c) { const int st = (r >> 4) * 2 + (c >> 5), rr = r & 15, cc = c & 31, ob = rr * 64 + cc * 2; return st * 1024 + (ob ^ (((ob >> 9) & 1) << 5)); }
__host__ __device__ __forceinline__ void stage_rc(int b, int& R, int& C) { const int st = b / 1024, sb = b % 1024, swz = sb ^ (((sb >> 9) & 1) << 5); R = (st >> 1) * 16 + swz / 64; C = (st & 1) * 32 + (swz % 64) / 2; }
__host__ __device__ __forceinline__ int perm32(int rho) { const int n = rho >> 4, i = rho & 15; return 8 * (i >> 2) + 4 * n + (i & 3); }

struct DUnit { int pm, pn; };
struct DenseOrder {
    typedef DUnit Unit; static constexpr bool GATHER = false;
    int nM, nN, nwg, G, c; const char* A; const char* Bt; size_t atile, btile; int wgm = WGM;
    __device__ __forceinline__ void init(int M, int N, int G_, int c_, const bf16_t* A_, int lda, const bf16_t* Bt_, int K) {
        nM = M / BM; nN = N / BM; nwg = nM * nN; G = G_; c = c_; A = (const char*)A_; Bt = (const char*)Bt_; atile = (size_t)BM * lda * 2; btile = (size_t)BM * K * 2; }
    __device__ __forceinline__ bool next(int i, Unit& u) const {
        const long L = (long)i * G + c; if (L >= nwg) return false;
        int wgid = (int)L; { const int q = nwg / NXCD, r = nwg % NXCD, xcd = wgid % NXCD, off = wgid / NXCD; wgid = (xcd < r ? xcd * (q + 1) : r * (q + 1) + (xcd - r) * q) + off; }
        const int nig = wgm * nN, gid = wgid / nig, fm = gid * wgm, gsz = (nM - fm) < wgm ? (nM - fm) : wgm;
        u.pm = fm + ((wgid % nig) % gsz); u.pn = (wgid % nig) / gsz; return true;
    }
    __device__ __forceinline__ const char* a_ptr(const Unit& u) const { return A + (size_t)u.pm * atile; }
    __device__ __forceinline__ const char* b_ptr(const Unit& u) const { return Bt + (size_t)u.pn * btile; }
    __device__ __forceinline__ unsigned a_voff(const Unit&, int, int, int) const { return 0u; }
};
struct HUnit { int pm, pn, hh; };
struct HeadOrder {
    typedef HUnit Unit; static constexpr bool GATHER = false;
    DenseOrder d;
    __device__ __forceinline__ bool next(int i, Unit& u) const { DUnit t; if (!d.next(i >> 2, t)) return false; u.pm = t.pm; u.pn = t.pn; u.hh = i & 3; return true; }
    __device__ __forceinline__ const char* a_ptr(const Unit& u) const { return d.A + ((size_t)((((u.pm >> 3) * 4 + u.hh) * 4) * SEQ + (u.pm & 7) * BM)) * 128; }
    __device__ __forceinline__ const char* b_ptr(const Unit& u) const { return d.Bt + (size_t)u.pn * d.btile + u.hh * 512; }
    __device__ __forceinline__ unsigned a_voff(const Unit&, int, int, int) const { return 0u; }
};
struct RetOrder {
    typedef DUnit Unit; static constexpr bool GATHER = false;
    DenseOrder d;
    __device__ __forceinline__ bool next(int i, Unit& u) const { return d.next(i, u); }
    __device__ __forceinline__ const char* a_ptr(const Unit& u) const { return d.A + ((size_t)(((u.pm >> 3) * 16) * SEQ + (u.pm & 7) * BM)) * 128; }
    __device__ __forceinline__ const char* b_ptr(const Unit& u) const { return d.b_ptr(u); }
    __device__ __forceinline__ unsigned a_voff(const Unit&, int, int, int) const { return 0u; }
};
struct MUnit { int pm, pn, e, pos0, cnt; };
template <bool GATHER_>
struct MoeOrder {
    typedef MUnit Unit; static constexpr bool GATHER = GATHER_;
    const LAS int* cnts; int G, c; const char* A; const char* Bt; size_t atile, bexp, btile; const int* stok; int lda;
    __device__ __forceinline__ bool next(int i, Unit& u) const {
        const int L = i * G + c; const int mt = L >> 2;
        int acc = 0, fe = -1, fpos = 0, fcnt = 0;
#pragma unroll
        for (int e = 0; e < NE; ++e) { const int ce = cnts[e]; const int te = (ce + 255) >> 8; if (mt >= acc && mt < acc + te) { fe = e; fpos = (mt - acc) << 8; fcnt = ce; } acc += te; }
        fe = rfl(fe); if (fe < 0) return false;
        u.pm = mt; u.pn = L & 3; u.e = fe; u.pos0 = rfl(fpos); u.cnt = rfl(fcnt); return true;
    }
    __device__ __forceinline__ const char* a_ptr(const Unit& u) const { return GATHER ? A : A + (size_t)u.pm * atile; }
    __device__ __forceinline__ const char* b_ptr(const Unit& u) const { return Bt + (size_t)u.e * bexp + (size_t)u.pn * btile; }
    __device__ __forceinline__ unsigned a_voff(const Unit& u, int h, int R, int C) const {
        int pos = u.pos0 + h * HALF + R; pos = pos < u.cnt ? pos : u.cnt - 1;
        const int tok = stok[(size_t)u.e * CAP + pos] >> 1;
        return (unsigned)(tok * lda + C) * 2u;
    }
};

template <class E, class = void> struct has_khook { static constexpr bool v = false; };
template <class E> struct has_khook<E, decltype((void)E::KHOOK)> { static constexpr bool v = E::KHOOK; };
template <class Epi, class Sched>
__device__ __forceinline__ void gemm_phase(LAS unsigned char* lds, const Sched& S, const Epi& E, const int K, const int lda, const int ldb, const size_t kstepA = 128) {
    typedef typename Sched::Unit Unit;
    int tid = threadIdx.x; asm volatile("" : "+v"(tid));
    const int wid = rfl(tid >> 6), lane = tid & 63, wr = wid >> 2, wc = wid & 3, fr = lane & 15, fq = lane >> 4;
    const int nt = K / BK;
    int Rr[2], Cc[2]; unsigned voffB[2];
#pragma unroll
    for (int i = 0; i < 2; ++i) { int R, C; stage_rc(tid * 16 + i * 8192, R, C); Rr[i] = R; Cc[i] = C; const int Rb = Epi::PERM ? ((R & ~31) + perm32(R & 31)) : R; voffB[i] = (unsigned)(Rb * ldb + C) * 2u; }
    const size_t kstep = (size_t)(BK * 2);
    const size_t hstepB = (size_t)HALF * ldb * 2;
    const unsigned ldsw = (unsigned)wid * 1024u;
    const int aoff = lds_byte(wr * 64 + fr, fq * 8), boff = lds_byte(wc * 32 + fr, fq * 8);
#define PG8_SA(b, h) (((b) * 2 + (h)) * HTB)
#define PG8_SB(b, h) ((4 + (b) * 2 + (h)) * HTB)
#define PG8_STAGE(bufoff, gbase, voff) do { _Pragma("unroll") for (int _i = 0; _i < 2; ++_i) \
        __builtin_amdgcn_global_load_lds((const unsigned*)((const char*)(gbase) + (voff)[_i]), (LAS unsigned*)(lds + (bufoff) + ldsw + _i * 8192), 16, 0, 0); } while (0)
#define PG8_LDA(dst, b, h) do { _Pragma("unroll") for (int m = 0; m < 4; ++m) _Pragma("unroll") for (int k = 0; k < 2; ++k) dst[m][k] = *(const LAS bf16x8*)(lds + PG8_SA(b, h) + aoff + m * 2048 + k * 1024); } while (0)
#define PG8_LDB(dst, b, h) do { _Pragma("unroll") for (int n = 0; n < 2; ++n) _Pragma("unroll") for (int k = 0; k < 2; ++k) dst[n][k] = *(const LAS bf16x8*)(lds + PG8_SB(b, h) + boff + n * 2048 + k * 1024); } while (0)
#define PG8_MMA(ai, bj, At, Bt) do { __builtin_amdgcn_s_setprio(1); _Pragma("unroll") for (int m = 0; m < 4; ++m) _Pragma("unroll") for (int n = 0; n < 2; ++n) _Pragma("unroll") for (int k = 0; k < 2; ++k) \
        acc[ai][bj][m][n] = __builtin_amdgcn_mfma_f32_16x16x32_bf16(Bt[n][k], At[m][k], acc[ai][bj][m][n], 0, 0, 0); __builtin_amdgcn_s_setprio(0); } while (0)
#define PG8_WAIT_V(n) asm volatile("s_waitcnt vmcnt(" #n ")" ::: "memory")
#define PG8_WAIT_L(n) asm volatile("s_waitcnt lgkmcnt(" #n ")" ::: "memory")
#define PG8_BAR __builtin_amdgcn_s_barrier()
#define PG8_SCHED __builtin_amdgcn_sched_barrier(0)
    Unit cur, nxt; int ui = 0;
    if (!S.next(0, cur)) return;
    unsigned vAc[2][2], vAn[2][2];
#pragma unroll
    for (int h = 0; h < 2; ++h)
#pragma unroll
        for (int i = 0; i < 2; ++i) { vAc[h][i] = Sched::GATHER ? S.a_voff(cur, h, Rr[i], Cc[i]) : (unsigned)((h * HALF + Rr[i]) * lda + Cc[i]) * 2u; vAn[h][i] = vAc[h][i]; }
    f32x4 acc[2][2][4][2];
#pragma unroll
    for (int a = 0; a < 2; ++a)
#pragma unroll
        for (int b = 0; b < 2; ++b)
#pragma unroll
            for (int m = 0; m < 4; ++m)
#pragma unroll
                for (int n = 0; n < 2; ++n) acc[a][b][m][n] = (f32x4){0.f, 0.f, 0.f, 0.f};
    bf16x8 At[4][2], B0[2][2], B1[2][2];
    const char* cA = S.a_ptr(cur); const char* cB = S.b_ptr(cur);
    PG8_STAGE(PG8_SB(0, 0), cB, voffB); PG8_STAGE(PG8_SB(0, 1), cB + hstepB, voffB); PG8_STAGE(PG8_SA(0, 0), cA, vAc[0]); PG8_STAGE(PG8_SA(0, 1), cA, vAc[1]);
    if (wr == 1) PG8_BAR;
    PG8_WAIT_V(2); PG8_BAR;
    PG8_STAGE(PG8_SB(1, 0), cB + kstep, voffB); PG8_STAGE(PG8_SA(1, 0), cA + kstepA, vAc[0]); PG8_STAGE(PG8_SB(1, 1), cB + hstepB + kstep, voffB);
    PG8_WAIT_V(6); PG8_BAR;
    for (;;) {
        const bool has_next = S.next(ui + 1, nxt);
        const char* nA = has_next ? S.a_ptr(nxt) : cA; const char* nB = has_next ? S.b_ptr(nxt) : cB;
        if constexpr (Sched::GATHER) {
            if (has_next) {
#pragma unroll
                for (int h = 0; h < 2; ++h)
#pragma unroll
                    for (int i = 0; i < 2; ++i) vAn[h][i] = S.a_voff(nxt, h, Rr[i], Cc[i]);
            }
        }
        for (int t = 0; t < nt; t += 2) {
            const bool last = (t == nt - 2);
            if constexpr (has_khook<Epi>::v) { if (t != 0 && (t & 3) == 0) E.khook(acc, ui, t, wr, fr, lds); }
            size_t tk = (size_t)t * kstep; asm volatile("" : "+s"(tk));
            size_t tkA = (size_t)t * kstepA; asm volatile("" : "+s"(tkA));
            const char* a1 = cA + tkA + kstepA;
            const char* a2 = last ? nA : cA + tkA + 2 * kstepA; const char* b2 = last ? nB : cB + tk + 2 * kstep;
            const char* a3 = a2 + kstepA; const char* b3 = b2 + kstep;
            unsigned s0[2], s1[2];
#pragma unroll
            for (int i = 0; i < 2; ++i) { s0[i] = (Sched::GATHER && last) ? vAn[0][i] : vAc[0][i]; s1[i] = (Sched::GATHER && last) ? vAn[1][i] : vAc[1][i]; }
            PG8_LDB(B0, 0, 0); PG8_LDB(B1, 0, 1); PG8_SCHED; PG8_LDA(At, 0, 0); PG8_STAGE(PG8_SA(1, 1), a1, vAc[1]);
            PG8_WAIT_V(8); PG8_WAIT_L(0); PG8_BAR; PG8_MMA(0, 0, At, B0); PG8_MMA(0, 1, At, B1); PG8_BAR; PG8_SCHED;
            PG8_LDA(At, 0, 1); PG8_STAGE(PG8_SB(0, 0), b2, voffB); PG8_STAGE(PG8_SB(0, 1), b2 + hstepB, voffB); PG8_STAGE(PG8_SA(0, 0), a2, s0);
            PG8_WAIT_V(8); PG8_WAIT_L(0); PG8_BAR; PG8_MMA(1, 0, At, B0); PG8_MMA(1, 1, At, B1); PG8_BAR; PG8_SCHED;
            PG8_LDB(B0, 1, 0); PG8_LDB(B1, 1, 1); PG8_SCHED; PG8_LDA(At, 1, 0); PG8_STAGE(PG8_SA(0, 1), a2, s1);
            PG8_WAIT_V(8); PG8_WAIT_L(0); PG8_BAR; PG8_MMA(0, 0, At, B0); PG8_MMA(0, 1, At, B1); PG8_BAR; PG8_SCHED;
            PG8_LDA(At, 1, 1); PG8_STAGE(PG8_SB(1, 0), b3, voffB); PG8_STAGE(PG8_SB(1, 1), b3 + hstepB, voffB); PG8_STAGE(PG8_SA(1, 0), a3, s0);
            PG8_WAIT_V(8); PG8_WAIT_L(0); PG8_BAR; PG8_MMA(1, 0, At, B0); PG8_MMA(1, 1, At, B1); PG8_BAR; PG8_SCHED;
        }
        if (wr == 0) PG8_BAR;
        bool keep = false;
        if constexpr (Epi::SUBUNITS) keep = E.sub(acc, cur, ui, wr, wc, fr, fq, lds); else if constexpr (has_khook<Epi>::v) E.fin(acc, cur, ui, wr, wc, fr, fq, lds); else E(acc, cur, wr, wc, fr, fq);
        if (!has_next) break;
        if (!keep) {
        float zz = 0.f; if constexpr (Epi::SUBUNITS) asm volatile("" : "+v"(zz));
#pragma unroll
        for (int a = 0; a < 2; ++a)
#pragma unroll
            for (int b = 0; b < 2; ++b)
#pragma unroll
                for (int m = 0; m < 4; ++m)
#pragma unroll
                    for (int n = 0; n < 2; ++n) acc[a][b][m][n] = (f32x4){zz, zz, zz, zz};
        }
        cur = nxt; cA = nA; cB = nB; ++ui;
        if constexpr (Sched::GATHER) {
#pragma unroll
            for (int h = 0; h < 2; ++h)
#pragma unroll
                for (int i = 0; i < 2; ++i) vAc[h][i] = vAn[h][i];
        }
        if (wr == 1) PG8_BAR;
    }
    PG8_WAIT_V(0);
    PG8_BAR;
#undef PG8_SA
#undef PG8_SB
#undef PG8_STAGE
#undef PG8_LDA
#undef PG8_LDB
#undef PG8_MMA
#undef PG8_WAIT_V
#undef PG8_WAIT_L
#undef PG8_BAR
#undef PG8_SCHED
}

struct EpiStore {
    static constexpr bool PERM = true, SUBUNITS = false;
    bf16_t* O; int ldc;
    __device__ __forceinline__ void operator()(const f32x4 (&acc)[2][2][4][2], const DUnit& u, int wr, int wc, int fr, int fq) const {
        const int row0 = u.pm * BM + wr * 64 + fr, col0 = u.pn * BM + wc * 32 + 8 * fq;
#pragma unroll
        for (int ai = 0; ai < 2; ++ai)
#pragma unroll
            for (int m = 0; m < 4; ++m) { bf16_t* rowp = O + (size_t)(row0 + ai * HALF + m * 16) * ldc + col0;
#pragma unroll
                for (int bj = 0; bj < 2; ++bj) { const f32x4 v0 = acc[ai][bj][m][0], v1 = acc[ai][bj][m][1];
                    u32x4 w; w.x = cvt_pk_bf16(v0[0], v0[1]); w.y = cvt_pk_bf16(v0[2], v0[3]); w.z = cvt_pk_bf16(v1[0], v1[1]); w.w = cvt_pk_bf16(v1[2], v1[3]);
                    *(u32x4*)(rowp + bj * HALF) = w; } }
    }
};
struct EpiProj {
    static constexpr bool PERM = true, SUBUNITS = false, PROBE2 = false;
    unsigned char* ws; const float* cosT; const float* sinT; const float* dec;
    __device__ __forceinline__ void operator()(const f32x4 (&acc)[2][2][4][2], const DUnit& u, int wr, int wc, int fr, int fq) const {
        const int b = u.pm >> 3, pos0 = (u.pm & 7) * BM + wr * 64 + fr;
        if (u.pn < 4) {
            const int i0 = 16 * wc + 4 * fq;
            const float* dtab = dec + (u.pn >> 1) * (4 * SEQ) + (2 * (u.pn & 1)) * SEQ;
            bf16_t* base = (bf16_t*)(ws + (u.pn < 2 ? WS_QB : WS_KB));
#pragma unroll
            for (int ai = 0; ai < 2; ++ai)
#pragma unroll
                for (int m = 0; m < 4; ++m) { const int pos = pos0 + ai * HALF + m * 16;
                    const f32x4 c4 = *(const f32x4*)(cosT + pos * 64 + i0), s4 = *(const f32x4*)(sinT + pos * 64 + i0);
#pragma unroll
                    for (int bj = 0; bj < 2; ++bj) { const f32x4 t1 = acc[ai][bj][m][0], t2 = acc[ai][bj][m][1]; const float dsc = dtab[bj * SEQ + pos];
                        const f32x4 o1 = (t1 * c4 - t2 * s4) * dsc, o2 = (t1 * s4 + t2 * c4) * dsc;
                        bf16_t* dst = base + ((size_t)((b * 4 + 2 * (u.pn & 1) + bj) * SEQ + pos)) * 128 + i0;
                        u32x2 w1, w2; w1.x = cvt_pk_bf16(o1[0], o1[1]); w1.y = cvt_pk_bf16(o1[2], o1[3]); w2.x = cvt_pk_bf16(o2[0], o2[1]); w2.y = cvt_pk_bf16(o2[2], o2[3]);
                        *(u32x2*)dst = w1; *(u32x2*)(dst + 64) = w2; } }
        } else if (u.pn < 12) {
            bf16_t* base = (bf16_t*)(ws + (u.pn < 8 ? WS_VB : WS_GB)); const int head = (u.pn - 4) & 3; const int e0 = 32 * (wc & 1) + 8 * fq;
#pragma unroll
            for (int ai = 0; ai < 2; ++ai)
#pragma unroll
                for (int m = 0; m < 4; ++m) { const int pos = pos0 + ai * HALF + m * 16;
#pragma unroll
                    for (int bj = 0; bj < 2; ++bj) { const f32x4 v0 = acc[ai][bj][m][0], v1 = acc[ai][bj][m][1];
                        u32x4 w; w.x = cvt_pk_bf16(v0[0], v0[1]); w.y = cvt_pk_bf16(v0[2], v0[3]); w.z = cvt_pk_bf16(v1[0], v1[1]); w.w = cvt_pk_bf16(v1[2], v1[3]);
                        *(u32x4*)(base + ((size_t)(((b * 4 + head) * 4 + 2 * bj + (wc >> 1)) * SEQ + pos)) * 64 + e0) = w; } }
        } else if (u.pn >= 14) {
            unsigned char* GA = ws + WS_GATE;
            const int col0 = (u.pn - 14) * BM + wc * 32 + 8 * fq;
#pragma unroll
            for (int ai = 0; ai < 2; ++ai)
#pragma unroll
                for (int m = 0; m < 4; ++m) {
#pragma unroll
                    for (int bj = 0; bj < 2; ++bj) { const f32x4 v0 = acc[ai][bj][m][0], v1 = acc[ai][bj][m][1];
                        unsigned q[8];
#pragma unroll
                        for (int k = 0; k < 4; ++k) { q[k] = (unsigned)(sigmoid_f(v0[k]) * 255.0f + 0.5f); q[4 + k] = (unsigned)(sigmoid_f(v1[k]) * 255.0f + 0.5f); }
                        u32x2 w; w.x = q[0] | (q[1] << 8) | (q[2] << 16) | (q[3] << 24); w.y = q[4] | (q[5] << 8) | (q[6] << 16) | (q[7] << 24);
                        *(u32x2*)(GA + gate_off(u.pm, u.pn - 14, ai, m, bj, wr * 256 + wc * 64 + fq * 16 + fr)) = w; } }
        } else {
            bf16_t* U = (bf16_t*)(ws + WS_U);
            const int col0 = (u.pn - 12) * BM + wc * 32 + 8 * fq;
#pragma unroll
            for (int ai = 0; ai < 2; ++ai)
#pragma unroll
                for (int m = 0; m < 4; ++m) { bf16_t* rowp = U + (size_t)(b * SEQ + pos0 + ai * HALF + m * 16) * 512 + col0;
#pragma unroll
                    for (int bj = 0; bj < 2; ++bj) { const f32x4 v0 = acc[ai][bj][m][0], v1 = acc[ai][bj][m][1];
                        u32x4 w; w.x = cvt_pk_bf16(v0[0], v0[1]); w.y = cvt_pk_bf16(v0[2], v0[3]); w.z = cvt_pk_bf16(v1[0], v1[1]); w.w = cvt_pk_bf16(v1[2], v1[3]);
                        *(u32x4*)(rowp + bj * HALF) = w; } }
        }
    }
};
constexpr int LDS_RTAB = 131072 + 512, RTAB_MAXU = 6;
struct EpiRet {
    static constexpr bool PERM = true, SUBUNITS = true;
    const float* ssq; const unsigned char* gate; bf16_t* O;
    __device__ __forceinline__ void fill_table(const DUnit& u, int ti, int tid, LAS unsigned char* lds) const {
        if (tid < 256) { const float* sp = ssq + (size_t)(u.pm * BM + tid) * 16; float rs[4];
#pragma unroll
            for (int h = 0; h < 4; ++h) { const f32x4 s4 = *(const f32x4*)(sp + 4 * h); rs[h] = rsqrtf(((s4[0] + s4[1]) + (s4[2] + s4[3])) * (1.0f / 256.0f) + EPS); }
            *(LAS f32x4*)(lds + LDS_RTAB + ti * 4096 + tid * 16) = (f32x4){rs[0] / rs[1], rs[1] / rs[2], rs[2] / rs[3], rs[3]}; }
    }
    __device__ __forceinline__ bool sub(f32x4 (&acc)[2][2][4][2], const HUnit& u, int ui, int wr, int wc, int fr, int fq, LAS unsigned char* lds) const {
        unsigned tb = (unsigned)(LDS_RTAB + (ui >> 2) * 4096 + (wr * 64 + fr) * 16 + u.hh * 4); asm volatile("" : "+v"(tb));
        if (u.hh < 3) {
#pragma unroll
            for (int ai = 0; ai < 2; ++ai)
#pragma unroll
                for (int m = 0; m < 4; ++m) { const float r = *(const LAS float*)(lds + tb + (ai * HALF + m * 16) * 16);
#pragma unroll
                    for (int bj = 0; bj < 2; ++bj)
#pragma unroll
                        for (int n = 0; n < 2; ++n) acc[ai][bj][m][n] = acc[ai][bj][m][n] * r; }
            return true;
        }
        const int col0 = u.pn * BM + wc * 32 + 8 * fq;
#pragma unroll
        for (int ai = 0; ai < 2; ++ai) {
            u32x2 gva[4][2];
#pragma unroll
            for (int m = 0; m < 4; ++m)
#pragma unroll
                for (int bj = 0; bj < 2; ++bj) gva[m][bj] = *(const u32x2*)(gate + gate_off(u.pm, u.pn, ai, m, bj, wr * 256 + wc * 64 + fq * 16 + fr));
#pragma unroll
            for (int m = 0; m < 4; ++m) { const int rl = ai * HALF + wr * 64 + m * 16 + fr; const float r = *(const LAS float*)(lds + tb + (ai * HALF + m * 16) * 16); const size_t row = (size_t)(u.pm * BM + rl);
#pragma unroll
                for (int bj = 0; bj < 2; ++bj) { const int col = col0 + bj * HALF;
                    float sg[8]; unpack_u8x8(gva[m][bj], sg);
                    const f32x4 v0 = acc[ai][bj][m][0] * r, v1 = acc[ai][bj][m][1] * r;
                    u32x4 w;
                    w.x = cvt_pk_bf16(sg[0] * v0[0], sg[1] * v0[1]); w.y = cvt_pk_bf16(sg[2] * v0[2], sg[3] * v0[3]);
                    w.z = cvt_pk_bf16(sg[4] * v1[0], sg[5] * v1[1]); w.w = cvt_pk_bf16(sg[6] * v1[2], sg[7] * v1[3]);
                    *(u32x4*)((unsigned char*)O + m1_off(u.pm, u.pn, ai, m, bj, wr * 256 + wc * 64 + fq * 16 + fr)) = w; } }
        }
        return false;
    }
};
struct EpiRetK {
    static constexpr bool PERM = true, SUBUNITS = false, KHOOK = true;
    const float* ssq; const unsigned char* gate; bf16_t* O;
    __device__ __forceinline__ void fill_table(const DUnit& u, int ti, int tid, LAS unsigned char* lds) const {
        if (tid < 256) { const float* sp = ssq + (size_t)(u.pm * BM + tid) * 16; float rs[4];
#pragma unroll
            for (int h = 0; h < 4; ++h) { const f32x4 s4 = *(const f32x4*)(sp + 4 * h); rs[h] = rsqrtf(((s4[0] + s4[1]) + (s4[2] + s4[3])) * (1.0f / 256.0f) + EPS); }
            *(LAS f32x4*)(lds + LDS_RTAB + ti * 4096 + tid * 16) = (f32x4){rs[0] / rs[1], rs[1] / rs[2], rs[2] / rs[3], rs[3]}; }
    }
    __device__ __forceinline__ void khook(f32x4 (&acc)[2][2][4][2], int ui, int t, int, int, LAS unsigned char* lds) const {
        int tid = threadIdx.x; asm volatile("" : "+v"(tid));
        const int wr = tid >> 8, fr = tid & 15;
        unsigned tb = (unsigned)(LDS_RTAB + ui * 4096 + (wr * 64 + fr) * 16 + ((t >> 2) - 1) * 4); asm volatile("" : "+v"(tb));
#pragma unroll
        for (int ai = 0; ai < 2; ++ai)
#pragma unroll
            for (int m = 0; m < 4; ++m) { const float r = *(const LAS float*)(lds + tb + (ai * HALF + m * 16) * 16);
#pragma unroll
                for (int bj = 0; bj < 2; ++bj)
#pragma unroll
                    for (int n = 0; n < 2; ++n) acc[ai][bj][m][n] = acc[ai][bj][m][n] * r; }
    }
    __device__ __forceinline__ void operator()(const f32x4 (&acc)[2][2][4][2], const DUnit& u, int wr, int wc, int fr, int fq) const { }
    __device__ __forceinline__ void fin(const f32x4 (&acc)[2][2][4][2], const DUnit& u, int ui, int, int, int, int, LAS unsigned char* lds) const {
        int tid = threadIdx.x; asm volatile("" : "+v"(tid));
        const int wr = tid >> 8, wc = (tid >> 6) & 3, fr = tid & 15, fq = (tid & 63) >> 4;
        unsigned tb = (unsigned)(LDS_RTAB + ui * 4096 + (wr * 64 + fr) * 16 + 12); asm volatile("" : "+v"(tb));
        const int col0 = u.pn * BM + wc * 32 + 8 * fq;
#pragma unroll
        for (int ai = 0; ai < 2; ++ai) {
            u32x2 gva[4][2];
#pragma unroll
            for (int m = 0; m < 4; ++m)
#pragma unroll
                for (int bj = 0; bj < 2; ++bj) gva[m][bj] = *(const u32x2*)(gate + gate_off(u.pm, u.pn, ai, m, bj, wr * 256 + wc * 64 + fq * 16 + fr));
#pragma unroll
            for (int m = 0; m < 4; ++m) { const int rl = ai * HALF + wr * 64 + m * 16 + fr; const float r = *(const LAS float*)(lds + tb + (ai * HALF + m * 16) * 16); const size_t row = (size_t)(u.pm * BM + rl);
#pragma unroll
                for (int bj = 0; bj < 2; ++bj) { const int col = col0 + bj * HALF;
                    float sg[8]; unpack_u8x8(gva[m][bj], sg);
                    const f32x4 v0 = acc[ai][bj][m][0] * r, v1 = acc[ai][bj][m][1] * r;
                    u32x4 w;
                    w.x = cvt_pk_bf16(sg[0] * v0[0], sg[1] * v0[1]); w.y = cvt_pk_bf16(sg[2] * v0[2], sg[3] * v0[3]);
                    w.z = cvt_pk_bf16(sg[4] * v1[0], sg[5] * v1[1]); w.w = cvt_pk_bf16(sg[6] * v1[2], sg[7] * v1[3]);
                    *(u32x4*)((unsigned char*)O + m1_off(u.pm, u.pn, ai, m, bj, wr * 256 + wc * 64 + fq * 16 + fr)) = w; } }
        }
    }
};
template <bool ADD>
struct EpiGate {
    static constexpr bool PERM = true, SUBUNITS = false;
    const unsigned char* gate; int ldg; const bf16_t* base; int ldb; bf16_t* O; int ldc;
    __device__ __forceinline__ void operator()(const f32x4 (&acc)[2][2][4][2], const DUnit& u, int wr, int wc, int fr, int fq) const {
        const int row0 = u.pm * BM + wr * 64 + fr, col0 = u.pn * BM + wc * 32 + 8 * fq;
#pragma unroll
        for (int ai = 0; ai < 2; ++ai) {
            u32x2 gv[4][2]; u32x4 bv[4][2];
#pragma unroll
            for (int m = 0; m < 4; ++m)
#pragma unroll
                for (int bj = 0; bj < 2; ++bj) { const size_t row = (size_t)(row0 + ai * HALF + m * 16); const int col = col0 + bj * HALF;
                    gv[m][bj] = *(const u32x2*)(gate + gate_off(u.pm, ldg + u.pn, ai, m, bj, wr * 256 + wc * 64 + fq * 16 + fr)); bv[m][bj] = (u32x4){0u, 0u, 0u, 0u}; if (ADD) bv[m][bj] = *(const u32x4*)((const unsigned char*)base + m1_off(u.pm, u.pn, ai, m, bj, wr * 256 + wc * 64 + fq * 16 + fr)); }
#pragma unroll
            for (int m = 0; m < 4; ++m)
#pragma unroll
                for (int bj = 0; bj < 2; ++bj) { const size_t row = (size_t)(row0 + ai * HALF + m * 16); const int col = col0 + bj * HALF;
                    const u32x4 bb = bv[m][bj]; float sg[8]; unpack_u8x8(gv[m][bj], sg);
                    const f32x4 v0 = acc[ai][bj][m][0], v1 = acc[ai][bj][m][1];
                    float o[8];
                    o[0] = sg[0] * v0[0]; o[1] = sg[1] * v0[1]; o[2] = sg[2] * v0[2]; o[3] = sg[3] * v0[3];
                    o[4] = sg[4] * v1[0]; o[5] = sg[5] * v1[1]; o[6] = sg[6] * v1[2]; o[7] = sg[7] * v1[3];
                    if (ADD) { o[0] += bflo(bb.x); o[1] += bfhi(bb.x); o[2] += bflo(bb.y); o[3] += bfhi(bb.y); o[4] += bflo(bb.z); o[5] += bfhi(bb.z); o[6] += bflo(bb.w); o[7] += bfhi(bb.w); }
                    u32x4 w; w.x = cvt_pk_bf16(o[0], o[1]); w.y = cvt_pk_bf16(o[2], o[3]); w.z = cvt_pk_bf16(o[4], o[5]); w.w = cvt_pk_bf16(o[6], o[7]);
                    *(u32x4*)(O + row * ldc + col) = w; }
        }
    }
};
template <bool F32IN>
struct EpiResid {
    static constexpr bool PERM = true, SUBUNITS = false, PROBE2 = false;
    const float* xin32; const bf16_t* xin16; bf16_t* xout; const float* gvec;
    __device__ __forceinline__ void operator()(const f32x4 (&acc)[2][2][4][2], const DUnit& u, int wr, int wc, int fr, int fq) const {
        { int tid_ = threadIdx.x; asm volatile("" : "+v"(tid_)); wr = tid_ >> 8; wc = (tid_ >> 6) & 3; fr = tid_ & 15; fq = (tid_ & 63) >> 4; }
        const int row0 = u.pm * BM + wr * 64 + fr, col0 = u.pn * BM + wc * 32 + 8 * fq;
        const float* gp = gvec + (size_t)(u.pm >> 3) * 6144 + col0;
        f32x4 gv[2][2];
#pragma unroll
        for (int bj = 0; bj < 2; ++bj)
#pragma unroll
            for (int n = 0; n < 2; ++n) gv[bj][n] = *(const f32x4*)(gp + bj * HALF + n * 4);
#pragma unroll
        for (int ai = 0; ai < 2; ++ai) {
            f32x4 xv[4][2][2];
#pragma unroll
            for (int m = 0; m < 4; ++m)
#pragma unroll
                for (int bj = 0; bj < 2; ++bj) { const size_t off = (size_t)(row0 + ai * HALF + m * 16) * D + col0 + bj * HALF;
                    if (F32IN) { xv[m][bj][0] = *(const f32x4*)(xin32 + off); xv[m][bj][1] = *(const f32x4*)(xin32 + off + 4); }
                    else { const u32x4 xb = *(const u32x4*)(xin16 + off); xv[m][bj][0] = (f32x4){bflo(xb.x), bfhi(xb.x), bflo(xb.y), bfhi(xb.y)}; xv[m][bj][1] = (f32x4){bflo(xb.z), bfhi(xb.z), bflo(xb.w), bfhi(xb.w)}; } }
#pragma unroll
            for (int m = 0; m < 4; ++m)
#pragma unroll
                for (int bj = 0; bj < 2; ++bj) { const size_t off = (size_t)(row0 + ai * HALF + m * 16) * D + col0 + bj * HALF;
                    const f32x4 o0 = xv[m][bj][0] + gv[bj][0] * acc[ai][bj][m][0], o1 = xv[m][bj][1] + gv[bj][1] * acc[ai][bj][m][1];
                    u32x4 w; w.x = cvt_pk_bf16(o0[0], o0[1]); w.y = cvt_pk_bf16(o0[2], o0[3]); w.z = cvt_pk_bf16(o1[0], o1[1]); w.w = cvt_pk_bf16(o1[2], o1[3]);
                    *(u32x4*)(xout + off) = w; }
        }
    }
};
struct EpiGateUp {
    static constexpr bool PERM = true, SUBUNITS = false;
    bf16_t* act;
    __device__ __forceinline__ void operator()(const f32x4 (&acc)[2][2][4][2], const MUnit& u, int wr, int wc, int fr, int fq) const {
        const int r0 = wr * 64 + fr, col0 = u.pn * HALF + wc * 32 + 8 * fq;
#pragma unroll
        for (int ai = 0; ai < 2; ++ai)
#pragma unroll
            for (int m = 0; m < 4; ++m) { const int r = r0 + ai * HALF + m * 16;
                if (u.pos0 + r < u.cnt) {
                    const f32x4 g0 = acc[ai][0][m][0], g1 = acc[ai][0][m][1], u0 = acc[ai][1][m][0], u1 = acc[ai][1][m][1];
                    u32x4 w; w.x = cvt_pk_bf16(silu_f(g0[0]) * u0[0], silu_f(g0[1]) * u0[1]); w.y = cvt_pk_bf16(silu_f(g0[2]) * u0[2], silu_f(g0[3]) * u0[3]);
                    w.z = cvt_pk_bf16(silu_f(g1[0]) * u1[0], silu_f(g1[1]) * u1[1]); w.w = cvt_pk_bf16(silu_f(g1[2]) * u1[2], silu_f(g1[3]) * u1[3]);
                    *(u32x4*)(act + (size_t)(u.pm * BM + r) * DE + col0) = w; } }
    }
};
struct EpiDown {
    static constexpr bool PERM = true, SUBUNITS = false;
    bf16_t* ybuf; const int* stok; const float* sw;
    __device__ __forceinline__ void operator()(const f32x4 (&acc)[2][2][4][2], const MUnit& u, int wr, int wc, int fr, int fq) const {
        const int r0 = wr * 64 + fr, col0 = u.pn * BM + wc * 32 + 8 * fq;
#pragma unroll
        for (int ai = 0; ai < 2; ++ai)
#pragma unroll
            for (int m = 0; m < 4; ++m) { const int r = r0 + ai * HALF + m * 16;
                if (u.pos0 + r < u.cnt) {
                    const size_t si = (size_t)u.e * CAP + u.pos0 + r; const int meta = stok[si]; const float wv = sw[si];
                    bf16_t* rowp = ybuf + (size_t)meta * D + col0;
#pragma unroll
                    for (int bj = 0; bj < 2; ++bj) { const f32x4 v0 = acc[ai][bj][m][0] * wv, v1 = acc[ai][bj][m][1] * wv;
                        u32x4 w; w.x = cvt_pk_bf16(v0[0], v0[1]); w.y = cvt_pk_bf16(v0[2], v0[3]); w.z = cvt_pk_bf16(v1[0], v1[1]); w.w = cvt_pk_bf16(v1[2], v1[3]);
                        *(u32x4*)(rowp + bj * HALF) = w; } } }
    }
};
}

struct Params {
    const float *x, *c, *w_ada, *b_ada, *n1g, *n2g, *w_in, *w_ret_o, *pool_w, *pool_scale, *w_pool_o, *w_out, *w_router, *b_router, *w_eg, *w_eu, *w_ed, *final_g;
    float* out; unsigned char* ws; int ph_lo, ph_hi;
};

struct Ctx {
    LAS unsigned char* lds; int tid, lane, wave, G, bx;
};
__device__ __forceinline__ Ctx make_ctx(LAS unsigned char* lds) {
    Ctx F; int t = threadIdx.x; asm volatile("" : "+v"(t)); int bx = blockIdx.x; asm volatile("" : "+s"(bx));
    F.lds = lds; F.tid = t; F.lane = t & 63; F.wave = rfl(t >> 6); F.G = gridDim.x; F.bx = bx; return F;
}

__device__ __forceinline__ void phase_prologue(const Params& p, const Ctx& F) {
    LAS float* cond = (LAS float*)F.lds;
    LAS float* red = (LAS float*)(F.lds + 65536);
    for (int i = F.tid; i < NB * D; i += NTHR) { const float v = p.c[i]; cond[i] = silu_f(v); }
    __syncthreads();
    float* mod = (float*)(p.ws + WS_MOD);
    for (int item = F.bx; item < DEPTH * 96; item += F.G) {
        const int l = item / 96, jb = item % 96;
        const float* w = p.w_ada + (size_t)l * D * 6144 + jb * 64 + F.lane;
        float acc[NB];
#pragma unroll
        for (int b = 0; b < NB; ++b) acc[b] = 0.f;
#pragma unroll 4
        for (int dd = 0; dd < 128; ++dd) { const int d = F.wave * 128 + dd; const float wv = w[(size_t)d * 6144];
#pragma unroll
            for (int b = 0; b < NB; ++b) acc[b] += cond[b * D + d] * wv; }
#pragma unroll
        for (int b = 0; b < NB; ++b) red[(F.wave * NB + b) * 64 + F.lane] = acc[b];
        __syncthreads();
        for (int o = F.tid; o < NB * 64; o += NTHR) { const int b = o >> 6, ln = o & 63; float s = 0.f;
#pragma unroll
            for (int w8 = 0; w8 < 8; ++w8) s += red[(w8 * NB + b) * 64 + ln];
            mod[(size_t)(l * NB + b) * 6144 + jb * 64 + ln] = s + p.b_ada[l * 6144 + jb * 64 + ln]; }
        __syncthreads();
    }
    float* cosT = (float*)(p.ws + WS_ROPE); float* sinT = cosT + SEQ * 64;
    for (int i = F.bx * NTHR + F.tid; i < SEQ * 64; i += F.G * NTHR) { const int pos = i >> 6, fi = i & 63;
        const float freq = exp2f(-(float)fi * (13.287712379549449f / 64.0f));
        const float ang = (float)pos * freq;
        const float rev = ang * 0.15915494309189535f; const float fr = rev - floorf(rev);
        cosT[i] = __builtin_amdgcn_cosf(fr); sinT[i] = __builtin_amdgcn_sinf(fr); }
    float* dq = (float*)(p.ws + WS_DEC); float* dk = dq + 4 * SEQ;
    for (int i = F.bx * NTHR + F.tid; i < 4 * SEQ; i += F.G * NTHR) { const int h = i >> 11, pos = i & (SEQ - 1);
        const float lg = log2f(1.0f - exp2f(-5.0f - (float)h)); dq[i] = exp2f(lg * (float)pos); dk[i] = exp2f(-lg * (float)pos); }
}

__device__ __forceinline__ void transpose_item(const float* W, int N, bf16_t* WT, int Kd, int k0, int n0, int drow0, LAS float* scr, int lane, int rot = 0, int i0 = 0, int rot_half = 0, float scale = 1.0f) {
#pragma unroll 8
    for (int i = 0; i < 32; ++i) { const int kk = 2 * i + (lane >> 5); scr[kk * 33 + (lane & 31)] = W[(size_t)(k0 + kk) * N + n0 + (lane & 31)]; }
    asm volatile("s_waitcnt lgkmcnt(0)" ::: "memory");
    const int c = lane & 7;
#pragma unroll
    for (int j = 0; j < 4; ++j) { const int n = (lane >> 3) + 8 * j; const LAS float* s = scr + (8 * c) * 33 + n;
        u32x4 o; o.x = cvt_pk_bf16(s[0 * 33] * scale, s[1 * 33] * scale); o.y = cvt_pk_bf16(s[2 * 33] * scale, s[3 * 33] * scale); o.z = cvt_pk_bf16(s[4 * 33] * scale, s[5 * 33] * scale); o.w = cvt_pk_bf16(s[6 * 33] * scale, s[7 * 33] * scale);
        const int ii = i0 + n; const int drow = rot ? drow0 + 32 * (ii >> 4) + 8 * ((ii >> 2) & 3) + 4 * rot_half + (ii & 3) : drow0 + n;
        *(u32x4*)(WT + (size_t)drow * Kd + k0 + 8 * c) = o; }
    asm volatile("s_waitcnt lgkmcnt(0)" ::: "memory");
}
__device__ __forceinline__ void transpose_item64(const float* W, int N, bf16_t* WT, int Kd, int k0, int n0, int drow0, LAS float* scr, int lane) {
    const float* src = W + (size_t)k0 * N + n0 + lane;
#pragma unroll 16
    for (int kk = 0; kk < 64; ++kk) scr[kk * 65 + lane] = src[(size_t)kk * N];
    asm volatile("s_waitcnt lgkmcnt(0)" ::: "memory");
    const int c = lane & 7;
#pragma unroll
    for (int j = 0; j < 8; ++j) { const int n = (lane >> 3) + 8 * j; const LAS float* s = scr + (8 * c) * 65 + n;
        u32x4 o; o.x = cvt_pk_bf16(s[0 * 65], s[1 * 65]); o.y = cvt_pk_bf16(s[2 * 65], s[3 * 65]); o.z = cvt_pk_bf16(s[4 * 65], s[5 * 65]); o.w = cvt_pk_bf16(s[6 * 65], s[7 * 65]);
        *(u32x4*)(WT + (size_t)(drow0 + n) * Kd + k0 + 8 * c) = o; }
    asm volatile("s_waitcnt lgkmcnt(0)" ::: "memory");
}
__device__ __forceinline__ void convert_layer_weights(const Params& p, const Ctx& F, int l) {
    LAS float* scr = (LAS float*)(F.lds + F.wave * 17408);
    const int gw = F.bx * NWAVES + F.wave, NGW = F.G * NWAVES;
    constexpr int I_QK = 16 * 32, I_IN = 16 * 72, I_RO = 16 * 16, I_OUT = 16 * 16, I_G = 16 * 16 * 8, I_U = I_G, I_DN = 16 * 8 * 16, I_PE = 4 * 16 * 32;
    constexpr int NITEMS = I_QK + I_IN + I_RO + I_OUT + I_G + I_U + I_DN + I_PE;
    unsigned char* ws = p.ws;
    for (int it = gw; it < NITEMS; it += NGW) {
        int r = it;
        if (r < I_QK) { const int kb = r / 32, nb = r % 32; const int n0 = nb * 32;
            transpose_item(p.w_in + (size_t)l * D * INW, INW, (bf16_t*)(ws + WT_IN), D, kb * 64, n0, n0 & ~127, scr, F.lane, 1, n0 & 63, (n0 >> 6) & 1, n0 >= 512 ? 0.08838834764831845f : 1.0f);
            continue; } r -= I_QK;
        if (r < I_IN) { const int kb = r / 72, nb = r % 72; const int n0 = 1024 + nb * 64;
            transpose_item64(p.w_in + (size_t)l * D * INW, INW, (bf16_t*)(ws + WT_IN), D, kb * 64, n0, n0, scr, F.lane); continue; } r -= I_IN;
        if (r < I_RO) { const int kb = r / 16, nb = r % 16; transpose_item64(p.w_ret_o + (size_t)l * D * D, D, (bf16_t*)(ws + WT_RO), D, kb * 64, nb * 64, nb * 64, scr, F.lane); continue; } r -= I_RO;
        if (r < I_OUT) { const int kb = r / 16, nb = r % 16; transpose_item64(p.w_out + (size_t)l * D * D, D, (bf16_t*)(ws + WT_OUT), D, kb * 64, nb * 64, nb * 64, scr, F.lane); continue; } r -= I_OUT;
        if (r < I_G + I_U) { const int half = r / I_G; const int q = r % I_G; const int e = q / 128, kb = (q % 128) / 8, nb = q % 8; const int n0 = nb * 64;
            const float* W = (half ? p.w_eu : p.w_eg) + ((size_t)l * NE + e) * D * DE;
            transpose_item64(W, DE, (bf16_t*)(ws + WT_GU) + (size_t)e * 1024 * D, D, kb * 64, n0, (n0 >> 7) * 256 + half * 128 + (n0 & 127), scr, F.lane); continue; } r -= I_G + I_U;
        if (r < I_DN) { const int e = r / 128, kb = (r % 128) / 16, nb = r % 16;
            transpose_item64(p.w_ed + ((size_t)l * NE + e) * DE * D, D, (bf16_t*)(ws + WT_DN) + (size_t)e * D * DE, DE, kb * 64, nb * 64, nb * 64, scr, F.lane); continue; } r -= I_DN;
        {
            const int g = r / 512, nb = (r % 512) / 32, cb = r % 32; const int n = nb * 64 + F.lane, c0 = cb * 4;
            const float* pw = p.pool_w + ((size_t)(l * 4 + g) * 128 + c0) * 128; const float* ps = p.pool_scale + l * 512 + g * 128;
            for (int i = F.lane; i < 4 * 128; i += 64) scr[i] = pw[i] * ps[i & 127];
            asm volatile("s_waitcnt lgkmcnt(0)" ::: "memory");
            const float* wo = p.w_pool_o + ((size_t)l * 512 + g * 128) * D + n;
            float acc[4];
#pragma unroll
            for (int c = 0; c < 4; ++c) acc[c] = 0.f;
            for (int d0 = 0; d0 < 128; d0 += 32) {
                float tv[32];
#pragma unroll
                for (int i = 0; i < 32; ++i) tv[i] = wo[(size_t)(d0 + i) * D];
#pragma unroll
                for (int i = 0; i < 32; ++i)
#pragma unroll
                    for (int c = 0; c < 4; ++c) acc[c] += scr[c * 128 + d0 + i] * tv[i]; }
            u32x2 o0; o0.x = cvt_pk_bf16(acc[0], acc[1]); o0.y = cvt_pk_bf16(acc[2], acc[3]);
            *(u32x2*)((bf16_t*)(ws + WT_PE) + (size_t)n * 512 + g * 128 + c0) = o0;
            asm volatile("s_waitcnt lgkmcnt(0)" ::: "memory");
        }
    }
}

__device__ __forceinline__ void phase_norm1(const Params& p, const Ctx& F, int l, int nrep) {
    for (int rep = 0; rep < NREP(0); ++rep) convert_layer_weights(p, F, l);
    const float* mod = (const float*)(p.ws + WS_MOD);
    const bf16_t* ybuf = (const bf16_t*)(p.ws + WS_YBUF);
    bf16_t* H = (bf16_t*)(p.ws + WS_H);
    bf16_t* XB = (bf16_t*)(p.ws + WS_XB);
    const int gw = F.bx * NWAVES + F.wave, NGW = F.G * NWAVES;
    for (int rep = 0; rep < nrep; ++rep)
    for (int blk = gw; blk < T / 16; blk += NGW) {
        const bool dummy = rep + 1 < nrep;
        const int row0 = blk * 16, b = row0 / SEQ;
        const float* m1 = mod + (size_t)(l * NB + b) * 6144;
        f32x4 av[4], cv[4], g2v[4];
#pragma unroll
        for (int i = 0; i < 4; ++i) { const int d = i * 256 + F.lane * 4;
            const f32x4 g = *(const f32x4*)(p.n1g + l * D + d), sc = *(const f32x4*)(m1 + 1024 + d);
            av[i] = g * (sc + 1.0f); cv[i] = *(const f32x4*)(m1 + d);
            g2v[i] = (f32x4){0.f, 0.f, 0.f, 0.f};
            if (l > 0) g2v[i] = *(const f32x4*)(mod + (size_t)((l - 1) * NB + b) * 6144 + 5120 + d); }
        f32x4 nf[4]; u32x2 nxb[4], ny0[4], ny1[4];
#pragma unroll
        for (int i = 0; i < 4; ++i) { const int d = i * 256 + F.lane * 4; const size_t row = (size_t)row0;
            if (l == 0) nf[i] = *(const f32x4*)(p.x + row * D + d);
            else { nxb[i] = *(const u32x2*)(XB + row * D + d); ny0[i] = *(const u32x2*)(ybuf + (2 * row) * D + d); ny1[i] = *(const u32x2*)(ybuf + (2 * row + 1) * D + d); } }
        for (int r = 0; r < 16; ++r) {
            const size_t row = (size_t)(row0 + r);
            f32x4 v[4]; u32x2 y0[4], y1[4]; float ss = 0.f;
#pragma unroll
            for (int i = 0; i < 4; ++i) { if (l == 0) v[i] = nf[i]; else { v[i] = (f32x4){bflo(nxb[i].x), bfhi(nxb[i].x), bflo(nxb[i].y), bfhi(nxb[i].y)}; y0[i] = ny0[i]; y1[i] = ny1[i]; } }
            if (r + 1 < 16) {
#pragma unroll
                for (int i = 0; i < 4; ++i) { const int d = i * 256 + F.lane * 4; const size_t rn = row + 1;
                    if (l == 0) nf[i] = *(const f32x4*)(p.x + rn * D + d);
                    else { nxb[i] = *(const u32x2*)(XB + rn * D + d); ny0[i] = *(const u32x2*)(ybuf + (2 * rn) * D + d); ny1[i] = *(const u32x2*)(ybuf + (2 * rn + 1) * D + d); } } }
#pragma unroll
            for (int i = 0; i < 4; ++i) { const int d = i * 256 + F.lane * 4;
                if (l != 0) {
                    f32x4 ys; ys[0] = bflo(y0[i].x) + bflo(y1[i].x); ys[1] = bfhi(y0[i].x) + bfhi(y1[i].x); ys[2] = bflo(y0[i].y) + bflo(y1[i].y); ys[3] = bfhi(y0[i].y) + bfhi(y1[i].y);
                    v[i] = v[i] + g2v[i] * ys;
                    if (!dummy) { u32x2 xw; xw.x = cvt_pk_bf16(v[i][0], v[i][1]); xw.y = cvt_pk_bf16(v[i][2], v[i][3]); *(u32x2*)(XB + row * D + d) = xw; } }
                ss += (v[i][0] * v[i][0] + v[i][1] * v[i][1]) + (v[i][2] * v[i][2] + v[i][3] * v[i][3]); }
            const float rstd = rsqrtf(wave_sum(ss) * (1.0f / D) + EPS);
#pragma unroll
            for (int i = 0; i < 4; ++i) { const int d = i * 256 + F.lane * 4; const f32x4 h = v[i] * rstd * av[i] + cv[i];
                u32x2 w; w.x = cvt_pk_bf16(h[0], h[1]); w.y = cvt_pk_bf16(h[2], h[3]);
                *(u32x2*)(H + row * D + d) = w; }
        }
    }
}

constexpr int RSK = 272, RSV = 144;
typedef short s16x4 __attribute__((ext_vector_type(4)));
__device__ __forceinline__ bf16x8 tr16x2(const LAS unsigned char* a0, const LAS unsigned char* a1) {
    const s16x4 lo = __builtin_amdgcn_ds_read_tr16_b64_v4i16((LAS s16x4*)a0), hi = __builtin_amdgcn_ds_read_tr16_b64_v4i16((LAS s16x4*)a1);
    return (bf16x8){lo[0], lo[1], lo[2], lo[3], hi[0], hi[1], hi[2], hi[3]};
}
__device__ __forceinline__ void phase_ret2(const Params& p, const Ctx& F, int vcu) {
    LAS unsigned char* Kim = F.lds;
    LAS unsigned char* Vim = F.lds + 34816;
    LAS unsigned char* StT = F.lds + 71680;
    LAS unsigned char* Pim = F.lds + 106496 + F.wave * (16 * RSK);
    bf16_t* P = (bf16_t*)(p.ws + WS_U);
    float* ssq = (float*)(p.ws + WS_SSQ);
    const int w = F.wave, fr = F.lane & 15, fg = F.lane >> 4, tq = fr >> 2, tp = F.lane & 3;
    unsigned oRow = (unsigned)(fr * RSK + 16 * fg), oPw = (unsigned)(fr * RSK + 8 * fg), oSw = (unsigned)(fr * RSK + 32 * w + 8 * fg);
    unsigned oTk = (unsigned)((8 * fg + tq) * RSK + 32 * w + 8 * tp), oTv = (unsigned)((8 * fg + tq) * RSV + 8 * tp), oTp = (unsigned)((4 * fg + tq) * RSV + 8 * tp);
    unsigned oKs = (unsigned)((F.tid >> 4) * RSK + (F.tid & 15) * 16), oVs = (unsigned)((F.tid >> 3) * RSV + (F.tid & 7) * 16);
    asm volatile("" : "+v"(oRow), "+v"(oPw), "+v"(oSw), "+v"(oTk), "+v"(oTv), "+v"(oKs), "+v"(oVs), "+v"(oTp));
    for (int rep2 = 0; rep2 < NREP(2); ++rep2) { const bool dummy = rep2 + 1 < NREP(2);
    for (int u = vcu; u < NB * 16; u += F.G) {
        const int s = u & 3, h = (u >> 2) & 3, b = u >> 4;
        __syncthreads();
        { unsigned z0 = 0u; asm volatile("" : "+v"(z0));
          for (int i = F.tid; i < 64 * RSK / 16; i += NTHR) *(LAS u32x4*)(StT + i * 16) = (u32x4){z0, z0, z0, z0}; }
        f32x4 st[4];
#pragma unroll
        for (int i = 0; i < 4; ++i) st[i] = (f32x4){0.f, 0.f, 0.f, 0.f};
        const size_t rowb = (size_t)b * SEQ;
        const bf16_t* kbase = (const bf16_t*)(p.ws + WS_KB) + (size_t)((b * 4 + h) * SEQ) * 128; const bf16_t* qbase = (const bf16_t*)(p.ws + WS_QB) + (size_t)((b * 4 + h) * SEQ) * 128;
        bf16_t* vbase = (bf16_t*)(p.ws + WS_VB) + (size_t)(((b * 4 + h) * 4 + s) * SEQ) * 64; const bf16_t* gbase = (const bf16_t*)(p.ws + WS_GB) + (size_t)(((b * 4 + h) * 4 + s) * SEQ) * 64;
        u32x4 kr[4], vr[2], qr[4];
#define RET_LOAD_CHUNK(nn) do { \
            _Pragma("unroll") for (int i_ = 0; i_ < 4; ++i_) { const int id_ = F.tid + NTHR * i_; kr[i_] = *(const u32x4*)(kbase + (size_t)((nn) * 128 + (id_ >> 4)) * 128 + (id_ & 15) * 8); } \
            _Pragma("unroll") for (int i_ = 0; i_ < 2; ++i_) { const int id_ = F.tid + NTHR * i_; vr[i_] = *(const u32x4*)(vbase + (size_t)((nn) * 128 + (id_ >> 3)) * 64 + (id_ & 7) * 8); } \
            _Pragma("unroll") for (int k_ = 0; k_ < 4; ++k_) qr[k_] = *(const u32x4*)(qbase + (size_t)((nn) * 128 + 16 * w + fr) * 128 + 32 * k_ + 8 * fg); } while (0)
        RET_LOAD_CHUNK(0);
        for (int n = 0; n < 16; ++n) {
#pragma unroll
            for (int i = 0; i < 4; ++i) *(LAS u32x4*)(Kim + oKs + i * 32 * RSK) = kr[i];
#pragma unroll
            for (int i = 0; i < 2; ++i) *(LAS u32x4*)(Vim + oVs + i * 64 * RSV) = vr[i];
            bf16x8 qf[4];
#pragma unroll
            for (int ks = 0; ks < 4; ++ks) qf[ks] = __builtin_bit_cast(bf16x8, qr[ks]);
            if (n + 1 < 16) RET_LOAD_CHUNK(n + 1);
            const size_t row = rowb + n * 128 + 16 * w + fr;
            u32x2 gr[4];
#pragma unroll
            for (int u4 = 0; u4 < 4; ++u4) gr[u4] = *(const u32x2*)(gbase + (size_t)(n * 128 + 16 * w + fr) * 64 + 16 * u4 + 4 * fg);
            __syncthreads();
            if (NREP(18) > 1) __syncthreads();
            const LAS unsigned char* Scur = StT + (n & 1) * (64 * RSK); LAS unsigned char* Snxt = StT + ((n + 1) & 1) * (64 * RSK);
            f32x4 yi[4];
#pragma unroll
            for (int i = 0; i < 4; ++i) yi[i] = (f32x4){0.f, 0.f, 0.f, 0.f};
#pragma unroll
            for (int kp = 0; kp < 4; ++kp) {
                if (2 * kp <= w) {
                    f32x4 a0 = (f32x4){0.f, 0.f, 0.f, 0.f}, a1 = (f32x4){0.f, 0.f, 0.f, 0.f};
#pragma unroll
                    for (int ks = 0; ks < 4; ++ks) { const bf16x8 kf = *(const LAS bf16x8*)(Kim + oRow + 32 * kp * RSK + 64 * ks); a0 = __builtin_amdgcn_mfma_f32_16x16x32_bf16(kf, qf[ks], a0, 0, 0, 0); }
                    if (2 * kp + 1 <= w) {
#pragma unroll
                        for (int ks = 0; ks < 4; ++ks) { const bf16x8 kf = *(const LAS bf16x8*)(Kim + oRow + (32 * kp + 16) * RSK + 64 * ks); a1 = __builtin_amdgcn_mfma_f32_16x16x32_bf16(kf, qf[ks], a1, 0, 0, 0); }
                    }
                    if (2 * kp == w) {
#pragma unroll
                        for (int r = 0; r < 4; ++r) a0[r] = (fr >= 4 * fg + r) ? a0[r] : 0.f; }
                    if (2 * kp + 1 == w) {
#pragma unroll
                        for (int r = 0; r < 4; ++r) a1[r] = (fr >= 4 * fg + r) ? a1[r] : 0.f; }
                    const bf16x8 pf = __builtin_bit_cast(bf16x8, (u32x4){cvt_pk_bf16(a0[0], a0[1]), cvt_pk_bf16(a0[2], a0[3]), cvt_pk_bf16(a1[0], a1[1]), cvt_pk_bf16(a1[2], a1[3])});
#pragma unroll
                    for (int u4 = 0; u4 < 4; ++u4) { const LAS unsigned char* va = Vim + oTp + 32 * kp * RSV + 32 * u4;
                        const bf16x8 vf = tr16x2(va, va + 16 * RSV); yi[u4] = __builtin_amdgcn_mfma_f32_16x16x32_bf16(vf, pf, yi[u4], 0, 0, 0); }
                }
            }
#pragma unroll
            for (int ks = 0; ks < 4; ++ks)
#pragma unroll
                for (int u4 = 0; u4 < 4; ++u4) { const bf16x8 sf = *(const LAS bf16x8*)(Scur + oRow + 16 * u4 * RSK + 64 * ks); yi[u4] = __builtin_amdgcn_mfma_f32_16x16x32_bf16(sf, qf[ks], yi[u4], 0, 0, 0); }
            if (NREP(16) > 1) {
                f32x4 yd[4];
#pragma unroll
                for (int i = 0; i < 4; ++i) yd[i] = (f32x4){0.f, 0.f, 0.f, 0.f};
#pragma unroll
                for (int kp = 0; kp < 4; ++kp) {
                    if (2 * kp <= w) {
                        f32x4 a0 = (f32x4){0.f, 0.f, 0.f, 0.f}, a1 = (f32x4){0.f, 0.f, 0.f, 0.f};
#pragma unroll
                        for (int ks = 0; ks < 4; ++ks) { const bf16x8 kf = *(const volatile LAS bf16x8*)(Kim + oRow + 32 * kp * RSK + 64 * ks); a0 = __builtin_amdgcn_mfma_f32_16x16x32_bf16(kf, qf[ks], a0, 0, 0, 0); }
                        if (2 * kp + 1 <= w) {
#pragma unroll
                            for (int ks = 0; ks < 4; ++ks) { const bf16x8 kf = *(const volatile LAS bf16x8*)(Kim + oRow + (32 * kp + 16) * RSK + 64 * ks); a1 = __builtin_amdgcn_mfma_f32_16x16x32_bf16(kf, qf[ks], a1, 0, 0, 0); }
                        }
                        const bf16x8 pf = __builtin_bit_cast(bf16x8, (u32x4){cvt_pk_bf16(a0[0], a0[1]), cvt_pk_bf16(a0[2], a0[3]), cvt_pk_bf16(a1[0], a1[1]), cvt_pk_bf16(a1[2], a1[3])});
#pragma unroll
                        for (int u4 = 0; u4 < 4; ++u4) { const LAS unsigned char* va = Vim + oTp + 32 * kp * RSV + 32 * u4;
                            const bf16x8 vf = tr16x2(va, va + 16 * RSV); yd[u4] = __builtin_amdgcn_mfma_f32_16x16x32_bf16(vf, pf, yd[u4], 0, 0, 0); }
                    }
                }
#pragma unroll
                for (int ks = 0; ks < 4; ++ks)
#pragma unroll
                    for (int u4 = 0; u4 < 4; ++u4) { const bf16x8 sf = *(const volatile LAS bf16x8*)(Scur + oRow + 16 * u4 * RSK + 64 * ks); yd[u4] = __builtin_amdgcn_mfma_f32_16x16x32_bf16(sf, qf[ks], yd[u4], 0, 0, 0); }
                asm volatile("" :: "v"(yd[0]), "v"(yd[1]), "v"(yd[2]), "v"(yd[3]));
            }
            {
                float ss = 0.f;
#pragma unroll
                for (int u4 = 0; u4 < 4; ++u4) { const f32x4 y = yi[u4]; ss += (y[0] * y[0] + y[1] * y[1]) + (y[2] * y[2] + y[3] * y[3]);
                    u32x2 yw; yw.x = cvt_pk_bf16(silu_f(bflo(gr[u4].x)) * y[0], silu_f(bfhi(gr[u4].x)) * y[1]); yw.y = cvt_pk_bf16(silu_f(bflo(gr[u4].y)) * y[2], silu_f(bfhi(gr[u4].y)) * y[3]);
                    if (dummy) *(u32x2*)((bf16_t*)(p.ws + WS_SCR) + row * D + h * 256 + s * 64 + 16 * u4 + 4 * fg) = yw;
                    else *(u32x2*)(vbase + (size_t)(n * 128 + 16 * w + fr) * 64 + 16 * u4 + 4 * fg) = yw; }
                ss += __shfl_xor(ss, 16); ss += __shfl_xor(ss, 32);
                if (fg == 0) ssq[row * 16 + h * 4 + s] = ss;
            }
#pragma unroll
            for (int ks = 0; ks < 4; ++ks) {
                const LAS unsigned char* ka = Kim + oTk + 32 * ks * RSK;
                const bf16x8 kz = tr16x2(ka, ka + 4 * RSK);
#pragma unroll
                for (int u4 = 0; u4 < 4; ++u4) { const LAS unsigned char* va = Vim + oTv + 32 * ks * RSV + 32 * u4;
                    const bf16x8 vz = tr16x2(va, va + 4 * RSV); st[u4] = __builtin_amdgcn_mfma_f32_16x16x32_bf16(kz, vz, st[u4], 0, 0, 0); }
            }
            if (NREP(17) > 1) {
                f32x4 sd[4];
#pragma unroll
                for (int i = 0; i < 4; ++i) sd[i] = (f32x4){0.f, 0.f, 0.f, 0.f};
#pragma unroll
                for (int ks = 0; ks < 4; ++ks) {
                    const LAS unsigned char* ka = Kim + oTk + 32 * ks * RSK;
                    const bf16x8 kz = tr16x2(ka, ka + 4 * RSK);
#pragma unroll
                    for (int u4 = 0; u4 < 4; ++u4) { const LAS unsigned char* va = Vim + oTv + 32 * ks * RSV + 32 * u4;
                        const bf16x8 vz = tr16x2(va, va + 4 * RSV); sd[u4] = __builtin_amdgcn_mfma_f32_16x16x32_bf16(kz, vz, sd[u4], 0, 0, 0); }
                }
                asm volatile("" :: "v"(sd[0]), "v"(sd[1]), "v"(sd[2]), "v"(sd[3]));
            }
#pragma unroll
            for (int u4 = 0; u4 < 4; ++u4) { u32x2 sw2; sw2.x = cvt_pk_bf16(st[u4][0], st[u4][1]); sw2.y = cvt_pk_bf16(st[u4][2], st[u4][3]);
                *(LAS u32x2*)(Snxt + oSw + 16 * u4 * RSK) = sw2; }
            __syncthreads();
        }
#undef RET_LOAD_CHUNK
    }
    }
    for (int rep3 = 0; rep3 < NREP(14); ++rep3) {
    bf16_t* MX = (bf16_t*)(p.ws + WS_H);
    const int gw = F.bx * NWAVES + F.wave, NGW = F.G * NWAVES;
    const int c = F.lane * 8, grp = F.lane >> 4, win = 2 << grp;
    for (int blk = gw; blk < T / 8; blk += NGW) {
        const int row0 = blk * 8; const int pos0 = row0 & (SEQ - 1);
        u32x4 R[23];
#pragma unroll
        for (int i = 0; i < 23; ++i) R[i] = *(const u32x4*)(P + ((long)(row0 - 15 + i) * 512) + c);
        if (pos0 < 15) {
#pragma unroll
            for (int i = 0; i < 15; ++i) if (pos0 - 15 + i < 0) R[i] = (u32x4){0u, 0u, 0u, 0u}; }
        float acc[8];
#pragma unroll
        for (int k = 0; k < 8; ++k) acc[k] = 0.f;
#pragma clang loop unroll(full)
        for (int j = 0; j < 16; ++j) { u32x4 uv = R[15 - j]; if (!(j < win)) uv = (u32x4){0u, 0u, 0u, 0u};
            acc[0] += bflo(uv.x); acc[1] += bfhi(uv.x); acc[2] += bflo(uv.y); acc[3] += bfhi(uv.y); acc[4] += bflo(uv.z); acc[5] += bfhi(uv.z); acc[6] += bflo(uv.w); acc[7] += bfhi(uv.w); }
#pragma clang loop unroll(full)
        for (int r = 0; r < 8; ++r) {
            const int pos = pos0 + r; const int cnt = (pos + 1) < win ? (pos + 1) : win;
            if (r > 0) { const u32x4 nv = R[15 + r]; const u32x4 o2 = R[13 + r], o4 = R[11 + r], o8 = R[7 + r], o16 = R[r - 1 < 0 ? 0 : r - 1];
                u32x4 ov = grp == 0 ? o2 : (grp == 1 ? o4 : (grp == 2 ? o8 : o16));
                acc[0] += bflo(nv.x) - bflo(ov.x); acc[1] += bfhi(nv.x) - bfhi(ov.x); acc[2] += bflo(nv.y) - bflo(ov.y); acc[3] += bfhi(nv.y) - bfhi(ov.y);
                acc[4] += bflo(nv.z) - bflo(ov.z); acc[5] += bfhi(nv.z) - bfhi(ov.z); acc[6] += bflo(nv.w) - bflo(ov.w); acc[7] += bfhi(nv.w) - bfhi(ov.w); }
            const u32x4 cu = R[15 + r]; const float inv = 1.0f / (float)cnt;
            u32x4 wv; wv.x = cvt_pk_bf16(acc[0] * inv - bflo(cu.x), acc[1] * inv - bfhi(cu.x)); wv.y = cvt_pk_bf16(acc[2] * inv - bflo(cu.y), acc[3] * inv - bfhi(cu.y));
            wv.z = cvt_pk_bf16(acc[4] * inv - bflo(cu.z), acc[5] * inv - bfhi(cu.z)); wv.w = cvt_pk_bf16(acc[6] * inv - bflo(cu.w), acc[7] * inv - bfhi(cu.w));
            *(u32x4*)(MX + (size_t)(row0 + r) * 512 + c) = wv;
        }
    }
    }
}

__device__ __forceinline__ void phase_ret3(const Params& p, const Ctx& F, int vcu) {
    LAS unsigned char* Kb = F.lds;
    LAS unsigned char* Vb = F.lds + 65536;
    LAS unsigned char* StT = F.lds + 98304;
    bf16_t* P = (bf16_t*)(p.ws + WS_U);
    float* ssq = (float*)(p.ws + WS_SSQ);
    const int w = F.wave, lane = F.lane, fr = lane & 15, fg = lane >> 4, tq = fr >> 2, tp = lane & 3;
    unsigned oK0 = (unsigned)(fr * 256 + (((0 + fg) ^ fr) << 4)), oK1 = (unsigned)(fr * 256 + (((4 + fg) ^ fr) << 4)), oK2 = (unsigned)(fr * 256 + (((8 + fg) ^ fr) << 4)), oK3 = (unsigned)(fr * 256 + (((12 + fg) ^ fr) << 4));
    unsigned oKt = (unsigned)((4 * fg + tq) * 256 + (((2 * w + (tp >> 1)) ^ (4 * fg + tq)) << 4) + 8 * (tp & 1));
    unsigned oV0 = (unsigned)((4 * fg + tq) * 128 + (((0 + (tp >> 1)) ^ (4 * (fg & 1) + tq)) << 4) + 8 * (tp & 1)), oV1 = (unsigned)((4 * fg + tq) * 128 + (((2 + (tp >> 1)) ^ (4 * (fg & 1) + tq)) << 4) + 8 * (tp & 1));
    unsigned oV2 = (unsigned)((4 * fg + tq) * 128 + (((4 + (tp >> 1)) ^ (4 * (fg & 1) + tq)) << 4) + 8 * (tp & 1)), oV3 = (unsigned)((4 * fg + tq) * 128 + (((6 + (tp >> 1)) ^ (4 * (fg & 1) + tq)) << 4) + 8 * (tp & 1));
    unsigned oRow = (unsigned)(fr * RSK + 16 * fg), oSw = (unsigned)(fr * RSK + 32 * w + 8 * fg);
    asm volatile("" : "+v"(oK0), "+v"(oK1), "+v"(oK2), "+v"(oK3), "+v"(oKt), "+v"(oV0), "+v"(oV1), "+v"(oV2), "+v"(oV3), "+v"(oRow), "+v"(oSw));
    const int krow = lane >> 4, kch = lane & 15, vrow = lane >> 3, vch = lane & 7;
    for (int rep2 = 0; rep2 < NREP(2); ++rep2) { const bool dummy = rep2 + 1 < NREP(2);
    for (int u = vcu; u < NB * 16; u += F.G) {
        const int s = u & 3, h = (u >> 2) & 3, b = u >> 4;
        __syncthreads();
        { unsigned z0 = 0u; asm volatile("" : "+v"(z0));
          for (int i = F.tid; i < 64 * RSK / 16; i += NTHR) *(LAS u32x4*)(StT + i * 16) = (u32x4){z0, z0, z0, z0}; }
        f32x4 st[4];
#pragma unroll
        for (int i = 0; i < 4; ++i) st[i] = (f32x4){0.f, 0.f, 0.f, 0.f};
        const size_t rowb = (size_t)b * SEQ;
        const bf16_t* kbase = (const bf16_t*)(p.ws + WS_KB) + (size_t)((b * 4 + h) * SEQ) * 128; const bf16_t* qbase = (const bf16_t*)(p.ws + WS_QB) + (size_t)((b * 4 + h) * SEQ) * 128;
        bf16_t* vbase = (bf16_t*)(p.ws + WS_VB) + (size_t)(((b * 4 + h) * 4 + s) * SEQ) * 64; const bf16_t* gbase = (const bf16_t*)(p.ws + WS_GB) + (size_t)(((b * 4 + h) * 4 + s) * SEQ) * 64;
        u32x4 qr[4]; u32x2 grn[4];
#define RET_ISSUE_K(nn) do { \
            _Pragma("unroll") for (int i_ = 0; i_ < 4; ++i_) { const int r_ = 16 * w + 4 * i_ + krow; \
                __builtin_amdgcn_global_load_lds((const unsigned*)(kbase + (size_t)((nn) * 128 + r_) * 128 + ((kch ^ (r_ & 15)) << 3)), (LAS unsigned*)(Kb + ((nn) & 1) * 32768 + (16 * w + 4 * i_) * 256), 16, 0, 0); } } while (0)
#define RET_ISSUE_V(nn) do { \
            _Pragma("unroll") for (int i_ = 0; i_ < 2; ++i_) { const int r_ = 16 * w + 8 * i_ + vrow; \
                __builtin_amdgcn_global_load_lds((const unsigned*)(vbase + (size_t)((nn) * 128 + r_) * 64 + ((vch ^ (r_ & 7)) << 3)), (LAS unsigned*)(Vb + ((nn) & 1) * 16384 + (16 * w + 8 * i_) * 128), 16, 0, 0); } } while (0)
#define RET_ISSUE_Q(nn) do { \
            _Pragma("unroll") for (int k_ = 0; k_ < 4; ++k_) qr[k_] = *(const u32x4*)(qbase + (size_t)((nn) * 128 + 16 * w + fr) * 128 + 32 * k_ + 8 * fg); } while (0)
#define RET_ISSUE_G(nn) do { \
            _Pragma("unroll") for (int u_ = 0; u_ < 4; ++u_) grn[u_] = *(const u32x2*)(gbase + (size_t)((nn) * 128 + 16 * w + fr) * 64 + 16 * u_ + 4 * fg); } while (0)
#define RET_PIN() do { asm volatile("" ::: "memory"); __builtin_amdgcn_sched_barrier(0); } while (0)
#define RET_ISSUE(nn) do { \
            _Pragma("unroll") for (int i_ = 0; i_ < 4; ++i_) { const int r_ = 16 * w + 4 * i_ + krow; \
                __builtin_amdgcn_global_load_lds((const unsigned*)(kbase + (size_t)((nn) * 128 + r_) * 128 + ((kch ^ (r_ & 15)) << 3)), (LAS unsigned*)(Kb + ((nn) & 1) * 32768 + (16 * w + 4 * i_) * 256), 16, 0, 0); } \
            _Pragma("unroll") for (int i_ = 0; i_ < 2; ++i_) { const int r_ = 16 * w + 8 * i_ + vrow; \
                __builtin_amdgcn_global_load_lds((const unsigned*)(vbase + (size_t)((nn) * 128 + r_) * 64 + ((vch ^ (r_ & 7)) << 3)), (LAS unsigned*)(Vb + ((nn) & 1) * 16384 + (16 * w + 8 * i_) * 128), 16, 0, 0); } \
            _Pragma("unroll") for (int k_ = 0; k_ < 4; ++k_) qr[k_] = *(const u32x4*)(qbase + (size_t)((nn) * 128 + 16 * w + fr) * 128 + 32 * k_ + 8 * fg); \
            _Pragma("unroll") for (int u_ = 0; u_ < 4; ++u_) grn[u_] = *(const u32x2*)(gbase + (size_t)((nn) * 128 + 16 * w + fr) * 64 + 16 * u_ + 4 * fg); } while (0)
        RET_ISSUE(0);
        bf16x8 qf[4]; u32x2 gr[4];
#pragma unroll
        for (int ks = 0; ks < 4; ++ks) qf[ks] = __builtin_bit_cast(bf16x8, qr[ks]);
#pragma unroll
        for (int u4 = 0; u4 < 4; ++u4) gr[u4] = grn[u4];
        asm volatile("s_waitcnt vmcnt(0) lgkmcnt(0)" ::: "memory");
        for (int n = 0; n < 16; ++n) {
            __builtin_amdgcn_s_barrier();
            asm volatile("" ::: "memory");
            if (n + 1 < 16) RET_ISSUE_K(n + 1);
            RET_PIN();
            const LAS unsigned char* Kim = Kb + (n & 1) * 32768; const LAS unsigned char* Vim = Vb + (n & 1) * 16384;
            const LAS unsigned char* Scur = StT + (n & 1) * (64 * RSK); LAS unsigned char* Snxt = StT + ((n + 1) & 1) * (64 * RSK);
            const size_t row = rowb + n * 128 + 16 * w + fr;
            f32x4 yi[4];
#pragma unroll
            for (int i = 0; i < 4; ++i) yi[i] = (f32x4){0.f, 0.f, 0.f, 0.f};
#pragma unroll
            for (int kp = 0; kp < 4; ++kp) {
                if (kp == 2) { RET_PIN(); if (n + 1 < 16) RET_ISSUE_V(n + 1); RET_PIN(); }
                f32x4 a0 = (f32x4){0.f, 0.f, 0.f, 0.f}, a1 = (f32x4){0.f, 0.f, 0.f, 0.f};
                { const bf16x8 k0 = *(const LAS bf16x8*)(Kim + oK0 + 32 * kp * 256), k1 = *(const LAS bf16x8*)(Kim + oK1 + 32 * kp * 256), k2 = *(const LAS bf16x8*)(Kim + oK2 + 32 * kp * 256), k3 = *(const LAS bf16x8*)(Kim + oK3 + 32 * kp * 256);
                  a0 = __builtin_amdgcn_mfma_f32_16x16x32_bf16(k0, qf[0], a0, 0, 0, 0); a0 = __builtin_amdgcn_mfma_f32_16x16x32_bf16(k1, qf[1], a0, 0, 0, 0);
                  a0 = __builtin_amdgcn_mfma_f32_16x16x32_bf16(k2, qf[2], a0, 0, 0, 0); a0 = __builtin_amdgcn_mfma_f32_16x16x32_bf16(k3, qf[3], a0, 0, 0, 0); }
                { const bf16x8 k0 = *(const LAS bf16x8*)(Kim + oK0 + (32 * kp + 16) * 256), k1 = *(const LAS bf16x8*)(Kim + oK1 + (32 * kp + 16) * 256), k2 = *(const LAS bf16x8*)(Kim + oK2 + (32 * kp + 16) * 256), k3 = *(const LAS bf16x8*)(Kim + oK3 + (32 * kp + 16) * 256);
                  a1 = __builtin_amdgcn_mfma_f32_16x16x32_bf16(k0, qf[0], a1, 0, 0, 0); a1 = __builtin_amdgcn_mfma_f32_16x16x32_bf16(k1, qf[1], a1, 0, 0, 0);
                  a1 = __builtin_amdgcn_mfma_f32_16x16x32_bf16(k2, qf[2], a1, 0, 0, 0); a1 = __builtin_amdgcn_mfma_f32_16x16x32_bf16(k3, qf[3], a1, 0, 0, 0); }
                { const bool full0 = 2 * kp < w, diag0 = 2 * kp == w, full1 = 2 * kp + 1 < w, diag1 = 2 * kp + 1 == w;
#pragma unroll
                  for (int r = 0; r < 4; ++r) { const bool tri = fr >= 4 * fg + r;
                      a0[r] = (full0 || (diag0 && tri)) ? a0[r] : 0.f; a1[r] = (full1 || (diag1 && tri)) ? a1[r] : 0.f; } }
                const bf16x8 pf = __builtin_bit_cast(bf16x8, (u32x4){cvt_pk_bf16(a0[0], a0[1]), cvt_pk_bf16(a0[2], a0[3]), cvt_pk_bf16(a1[0], a1[1]), cvt_pk_bf16(a1[2], a1[3])});
                { const LAS unsigned char* v0 = Vim + oV0 + 32 * kp * 128; const LAS unsigned char* v1 = Vim + oV1 + 32 * kp * 128; const LAS unsigned char* v2 = Vim + oV2 + 32 * kp * 128; const LAS unsigned char* v3 = Vim + oV3 + 32 * kp * 128;
                  yi[0] = __builtin_amdgcn_mfma_f32_16x16x32_bf16(tr16x2(v0, v0 + 16 * 128), pf, yi[0], 0, 0, 0); yi[1] = __builtin_amdgcn_mfma_f32_16x16x32_bf16(tr16x2(v1, v1 + 16 * 128), pf, yi[1], 0, 0, 0);
                  yi[2] = __builtin_amdgcn_mfma_f32_16x16x32_bf16(tr16x2(v2, v2 + 16 * 128), pf, yi[2], 0, 0, 0); yi[3] = __builtin_amdgcn_mfma_f32_16x16x32_bf16(tr16x2(v3, v3 + 16 * 128), pf, yi[3], 0, 0, 0); }
            }
            RET_PIN(); if (n + 1 < 16) RET_ISSUE_Q(n + 1); RET_PIN();
#pragma unroll
            for (int ks = 0; ks < 4; ++ks)
#pragma unroll
                for (int u4 = 0; u4 < 4; ++u4) { const bf16x8 sf = *(const LAS bf16x8*)(Scur + oRow + 16 * u4 * RSK + 64 * ks); yi[u4] = __builtin_amdgcn_mfma_f32_16x16x32_bf16(sf, qf[ks], yi[u4], 0, 0, 0); }
            RET_PIN(); if (n + 1 < 16) RET_ISSUE_G(n + 1); RET_PIN();
#pragma unroll
            for (int ks = 0; ks < 4; ++ks) {
                const LAS unsigned char* ka = Kim + oKt + 32 * ks * 256;
                const bf16x8 kz = tr16x2(ka, ka + 16 * 256);
                const LAS unsigned char* v0 = Vim + oV0 + 32 * ks * 128; const LAS unsigned char* v1 = Vim + oV1 + 32 * ks * 128; const LAS unsigned char* v2 = Vim + oV2 + 32 * ks * 128; const LAS unsigned char* v3 = Vim + oV3 + 32 * ks * 128;
                st[0] = __builtin_amdgcn_mfma_f32_16x16x32_bf16(kz, tr16x2(v0, v0 + 16 * 128), st[0], 0, 0, 0); st[1] = __builtin_amdgcn_mfma_f32_16x16x32_bf16(kz, tr16x2(v1, v1 + 16 * 128), st[1], 0, 0, 0);
                st[2] = __builtin_amdgcn_mfma_f32_16x16x32_bf16(kz, tr16x2(v2, v2 + 16 * 128), st[2], 0, 0, 0); st[3] = __builtin_amdgcn_mfma_f32_16x16x32_bf16(kz, tr16x2(v3, v3 + 16 * 128), st[3], 0, 0, 0);
            }
#pragma unroll
            for (int u4 = 0; u4 < 4; ++u4) { u32x2 sw2; sw2.x = cvt_pk_bf16(st[u4][0], st[u4][1]); sw2.y = cvt_pk_bf16(st[u4][2], st[u4][3]);
                *(LAS u32x2*)(Snxt + oSw + 16 * u4 * RSK) = sw2; }
            float ss = 0.f; u32x2 yw[4];
#pragma unroll
            for (int u4 = 0; u4 < 4; ++u4) { const f32x4 y = yi[u4]; ss += (y[0] * y[0] + y[1] * y[1]) + (y[2] * y[2] + y[3] * y[3]);
                yw[u4].x = cvt_pk_bf16(silu_f(bflo(gr[u4].x)) * y[0], silu_f(bfhi(gr[u4].x)) * y[1]); yw[u4].y = cvt_pk_bf16(silu_f(bflo(gr[u4].y)) * y[2], silu_f(bfhi(gr[u4].y)) * y[3]); }
            ss += __shfl_xor(ss, 16); ss += __shfl_xor(ss, 32);
            asm volatile("s_waitcnt vmcnt(0) lgkmcnt(0)" ::: "memory");
#pragma unroll
            for (int ks = 0; ks < 4; ++ks) qf[ks] = __builtin_bit_cast(bf16x8, qr[ks]);
#pragma unroll
            for (int u4 = 0; u4 < 4; ++u4) gr[u4] = grn[u4];
            asm volatile("" ::: "memory");
#pragma unroll
            for (int u4 = 0; u4 < 4; ++u4) *(u32x2*)((dummy ? (bf16_t*)(p.ws + WS_SCR) + (size_t)(((b * 4 + h) * 4 + s) * SEQ) * 64 : vbase) + (size_t)(n * 128 + 16 * w + fr) * 64 + 16 * u4 + 4 * fg) = yw[u4];
            if (fg == 0) ssq[row * 16 + h * 4 + s] = ss;
        }
#undef RET_ISSUE
#undef RET_ISSUE_K
#undef RET_ISSUE_V
#undef RET_ISSUE_Q
#undef RET_ISSUE_G
#undef RET_PIN
    }
    }
    for (int rep3 = 0; rep3 < NREP(14); ++rep3) {
    bf16_t* MX = (bf16_t*)(p.ws + WS_H);
    const int gw = F.bx * NWAVES + F.wave, NGW = F.G * NWAVES;
    const int c = F.lane * 8, grp = F.lane >> 4, win = 2 << grp;
    for (int blk = gw; blk < T / 8; blk += NGW) {
        const int row0 = blk * 8; const int pos0 = row0 & (SEQ - 1);
        u32x4 R[23];
#pragma unroll
        for (int i = 0; i < 23; ++i) R[i] = *(const u32x4*)(P + ((long)(row0 - 15 + i) * 512) + c);
        if (pos0 < 15) {
#pragma unroll
            for (int i = 0; i < 15; ++i) if (pos0 - 15 + i < 0) R[i] = (u32x4){0u, 0u, 0u, 0u}; }
        float acc[8];
#pragma unroll
        for (int k = 0; k < 8; ++k) acc[k] = 0.f;
#pragma clang loop unroll(full)
        for (int j = 0; j < 16; ++j) { u32x4 uv = R[15 - j]; if (!(j < win)) uv = (u32x4){0u, 0u, 0u, 0u};
            acc[0] += bflo(uv.x); acc[1] += bfhi(uv.x); acc[2] += bflo(uv.y); acc[3] += bfhi(uv.y); acc[4] += bflo(uv.z); acc[5] += bfhi(uv.z); acc[6] += bflo(uv.w); acc[7] += bfhi(uv.w); }
#pragma clang loop unroll(full)
        for (int r = 0; r < 8; ++r) {
            const int pos = pos0 + r; const int cnt = (pos + 1) < win ? (pos + 1) : win;
            if (r > 0) { const u32x4 nv = R[15 + r]; const u32x4 o2 = R[13 + r], o4 = R[11 + r], o8 = R[7 + r], o16 = R[r - 1 < 0 ? 0 : r - 1];
                u32x4 ov = grp == 0 ? o2 : (grp == 1 ? o4 : (grp == 2 ? o8 : o16));
                acc[0] += bflo(nv.x) - bflo(ov.x); acc[1] += bfhi(nv.x) - bfhi(ov.x); acc[2] += bflo(nv.y) - bflo(ov.y); acc[3] += bfhi(nv.y) - bfhi(ov.y);
                acc[4] += bflo(nv.z) - bflo(ov.z); acc[5] += bfhi(nv.z) - bfhi(ov.z); acc[6] += bflo(nv.w) - bflo(ov.w); acc[7] += bfhi(nv.w) - bfhi(ov.w); }
            const u32x4 cu = R[15 + r]; const float inv = 1.0f / (float)cnt;
            u32x4 wv; wv.x = cvt_pk_bf16(acc[0] * inv - bflo(cu.x), acc[1] * inv - bfhi(cu.x)); wv.y = cvt_pk_bf16(acc[2] * inv - bflo(cu.y), acc[3] * inv - bfhi(cu.y));
            wv.z = cvt_pk_bf16(acc[4] * inv - bflo(cu.z), acc[5] * inv - bfhi(cu.z)); wv.w = cvt_pk_bf16(acc[6] * inv - bflo(cu.w), acc[7] * inv - bfhi(cu.w));
            *(u32x4*)(MX + (size_t)(row0 + r) * 512 + c) = wv;
        }
    }
    }
}

__device__ __forceinline__ void phase_norm2_route(const Params& p, const Ctx& F, int l, bool dummy = false) {
    LAS float* wr = (LAS float*)F.lds;
    LAS int* se = (LAS int*)(F.lds + 81920);
    LAS float* swl = (LAS float*)(F.lds + 81920 + 1024);
    LAS int* spos = (LAS int*)(F.lds + 81920 + 2048);
    LAS int* lcnt = (LAS int*)(F.lds + 81920 + 3072);
    LAS int* lbase = (LAS int*)(F.lds + 81920 + 3072 + 64);
    LAS float* lgt = (LAS float*)(F.lds + 81920 + 4096) + F.wave * 256;
    LAS float* avl = (LAS float*)(F.lds + 94208);
    LAS float* cvl = (LAS float*)(F.lds + 98304);
    for (int i = F.tid; i < D * NE; i += NTHR) wr[(i >> 4) * 20 + (i & 15)] = p.w_router[i];
    const float* mod = (const float*)(p.ws + WS_MOD);
    bf16_t* H = (bf16_t*)(p.ws + WS_H);
    unsigned* counts = (unsigned*)(p.ws + WS_CTL) + CW_CNT + l * 64 + (dummy ? 16 : 0);
    int* stok = (int*)(p.ws + (dummy ? WS_SCR : WS_STOK)); float* sw = (float*)(p.ws + (dummy ? WS_SCR + 4 * MiB : WS_SW));
    const int lane = F.lane;
    const bool b5 = (lane & 32) != 0, b4 = (lane & 16) != 0, b3 = (lane & 8) != 0, b2 = (lane & 4) != 0;
    for (int pass = F.bx; pass < T / 128; pass += F.G) {
        __syncthreads();
        if (F.tid < 16) lcnt[F.tid] = 0;
        const int row0 = pass * 128 + F.wave * 16, b = row0 / SEQ;
        const float* m1 = mod + (size_t)(l * NB + b) * 6144;
        for (int d = F.tid; d < D; d += NTHR) { avl[d] = p.n2g[l * D + d] * (m1[4096 + d] + 1.0f); cvl[d] = m1[3072 + d]; }
        const bf16_t* XB = (const bf16_t*)(p.ws + WS_XB);
        constexpr int TG = 4;
        unsigned nx[TG][8];
#pragma unroll
        for (int tk = 0; tk < TG; ++tk)
#pragma unroll
            for (int i = 0; i < 8; ++i) nx[tk][i] = *(const unsigned*)(XB + (size_t)(row0 + tk) * D + i * 128 + 2 * lane);
        __syncthreads();
        for (int r0 = 0; r0 < 16; r0 += TG) {
            int ln = lane; asm volatile("" : "+v"(ln));
            unsigned cur[TG][8]; float rstd[TG];
#pragma unroll
            for (int tk = 0; tk < TG; ++tk) { float ss = 0.f;
#pragma unroll
                for (int i = 0; i < 8; ++i) { cur[tk][i] = nx[tk][i]; const float a0 = bflo(cur[tk][i]), a1 = bfhi(cur[tk][i]); ss += a0 * a0 + a1 * a1; }
                rstd[tk] = rsqrtf(wave_sum(ss) * (1.0f / D) + EPS); }
            if (r0 + TG < 16) {
#pragma unroll
                for (int tk = 0; tk < TG; ++tk)
#pragma unroll
                    for (int i = 0; i < 8; ++i) nx[tk][i] = *(const unsigned*)(XB + (size_t)(row0 + r0 + TG + tk) * D + i * 128 + 2 * ln); }
            f32x2 lg2[TG][8];
#pragma unroll
            for (int tk = 0; tk < TG; ++tk)
#pragma unroll
                for (int j = 0; j < 8; ++j) lg2[tk][j] = (f32x2){0.f, 0.f};
#pragma unroll
            for (int i = 0; i < 8; ++i) {
                f32x2 hv[TG]; const f32x2 avi = *(const LAS f32x2*)(avl + i * 128 + 2 * ln), cvi = *(const LAS f32x2*)(cvl + i * 128 + 2 * ln);
#pragma unroll
                for (int tk = 0; tk < TG; ++tk) { const f32x2 v = (f32x2){bflo(cur[tk][i]), bfhi(cur[tk][i])}; hv[tk] = v * rstd[tk] * avi + cvi;
                    *(unsigned*)(H + (size_t)(row0 + r0 + tk) * D + i * 128 + 2 * ln) = cvt_pk_bf16(hv[tk][0], hv[tk][1]); }
                const LAS f32x4* wp = (const LAS f32x4*)(wr + (i * 128 + 2 * ln) * 20);
#pragma unroll
                for (int q = 0; q < 2; ++q) { const f32x4 w0 = wp[5 * q], w1 = wp[5 * q + 1], w2 = wp[5 * q + 2], w3 = wp[5 * q + 3];
                    const f32x2 wv[8] = {{w0[0], w0[1]}, {w0[2], w0[3]}, {w1[0], w1[1]}, {w1[2], w1[3]}, {w2[0], w2[1]}, {w2[2], w2[3]}, {w3[0], w3[1]}, {w3[2], w3[3]}};
#pragma unroll
                    for (int tk = 0; tk < TG; ++tk) { const float hh = hv[tk][q]; const f32x2 h2 = (f32x2){hh, hh};
#pragma unroll
                        for (int j = 0; j < 8; ++j) lg2[tk][j] = __builtin_elementwise_fma(h2, wv[j], lg2[tk][j]); }
#pragma unroll
                    for (int tk = 0; tk < TG; ++tk) asm volatile("" : "+v"(lg2[tk][0]), "+v"(lg2[tk][1]), "+v"(lg2[tk][2]), "+v"(lg2[tk][3]), "+v"(lg2[tk][4]), "+v"(lg2[tk][5]), "+v"(lg2[tk][6]), "+v"(lg2[tk][7]) :: "memory"); }
            }
#pragma unroll
            for (int tk = 0; tk < TG; ++tk) {
                float lg[NE];
#pragma unroll
                for (int e = 0; e < NE; ++e) lg[e] = lg2[tk][e >> 1][e & 1];
                float k8[8], k4[4], k2[2];
#pragma unroll
                for (int i = 0; i < 8; ++i) { const float snd = b5 ? lg[i] : lg[i + 8]; k8[i] = (b5 ? lg[i + 8] : lg[i]) + __shfl_xor(snd, 32); }
#pragma unroll
                for (int i = 0; i < 4; ++i) { const float snd = b4 ? k8[i] : k8[i + 4]; k4[i] = (b4 ? k8[i + 4] : k8[i]) + __shfl_xor(snd, 16); }
#pragma unroll
                for (int i = 0; i < 2; ++i) { const float snd = b3 ? k4[i] : k4[i + 2]; k2[i] = (b3 ? k4[i + 2] : k4[i]) + __shfl_xor(snd, 8); }
                float k1; { const float snd = b2 ? k2[0] : k2[1]; k1 = (b2 ? k2[1] : k2[0]) + __shfl_xor(snd, 4); }
                k1 += __shfl_xor(k1, 1); k1 += __shfl_xor(k1, 2);
                if ((ln & 3) == 0) lgt[(r0 + tk) * 16 + (ln >> 2)] = k1;
            }
        }
        {
            const int t = lane & 15;
            float pr[NE]; float mx = -3.0e38f;
#pragma unroll
            for (int q = 0; q < 4; ++q) { const f32x4 x4 = *(const LAS f32x4*)(lgt + t * 16 + 4 * q); const f32x4 b4v = *(const f32x4*)(p.b_router + 4 * q);
                pr[4 * q] = x4[0] + b4v[0]; pr[4 * q + 1] = x4[1] + b4v[1]; pr[4 * q + 2] = x4[2] + b4v[2]; pr[4 * q + 3] = x4[3] + b4v[3]; }
#pragma unroll
            for (int e = 0; e < NE; ++e) mx = fmaxf(mx, pr[e]);
            float den = 0.f;
#pragma unroll
            for (int e = 0; e < NE; ++e) { pr[e] = __expf(pr[e] - mx); den += pr[e]; }
            const float rden = 1.0f / den;
#pragma unroll
            for (int e = 0; e < NE; ++e) pr[e] *= rden;
            float best = -1.0f; int sg = 0; float c0 = 0.f, c1 = 0.f, c2 = 0.f, c3 = 0.f;
#pragma unroll
            for (int g = 0; g < 4; ++g) { const float a0 = pr[4 * g], a1 = pr[4 * g + 1], a2 = pr[4 * g + 2], a3 = pr[4 * g + 3];
                const float hi01 = fmaxf(a0, a1), lo01 = fminf(a0, a1), hi23 = fmaxf(a2, a3), lo23 = fminf(a2, a3);
                const float m1v = fmaxf(hi01, hi23); const float m2v = fmaxf(fminf(hi01, hi23), fmaxf(lo01, lo23));
                const float gs = m1v + m2v;
                if (gs > best) { best = gs; sg = g; c0 = a0; c1 = a1; c2 = a2; c3 = a3; } }
            int i0 = 0; float p0 = c0;
            if (c1 > p0) { p0 = c1; i0 = 1; } if (c2 > p0) { p0 = c2; i0 = 2; } if (c3 > p0) { p0 = c3; i0 = 3; }
            int i1 = -1; float p1 = -1.0f;
            if (i0 != 0 && c0 > p1) { p1 = c0; i1 = 0; } if (i0 != 1 && c1 > p1) { p1 = c1; i1 = 1; } if (i0 != 2 && c2 > p1) { p1 = c2; i1 = 2; } if (i0 != 3 && c3 > p1) { p1 = c3; i1 = 3; }
            const float wsum = p0 + p1;
            if (lane < 16) { const int sl = (F.wave * 16 + t) * 2; se[sl] = sg * 4 + i0; se[sl + 1] = sg * 4 + i1; swl[sl] = p0 / wsum; swl[sl + 1] = p1 / wsum; }
        }
        __syncthreads();
        if (F.tid < 256) spos[F.tid] = atomicAdd((int*)&lcnt[se[F.tid]], 1);
        __syncthreads();
        if (F.tid < 16) lbase[F.tid] = (int)__hip_atomic_fetch_add(counts + F.tid, (unsigned)lcnt[F.tid], __ATOMIC_RELAXED, __HIP_MEMORY_SCOPE_AGENT);
        __syncthreads();
        if (F.tid < 256) { const int e = se[F.tid]; const int pos = lbase[e] + spos[F.tid]; const int tok = pass * 128 + (F.tid >> 1);
            stok[(size_t)e * CAP + pos] = tok * 2 + (F.tid & 1); sw[(size_t)e * CAP + pos] = swl[F.tid]; }
    }
    __syncthreads();
}

__device__ __forceinline__ void phase_final(const Params& p, const Ctx& F) {
    const float* mod = (const float*)(p.ws + WS_MOD);
    const bf16_t* ybuf = (const bf16_t*)(p.ws + WS_YBUF);
    const int gw = F.bx * NWAVES + F.wave, NGW = F.G * NWAVES;
    for (int blk = gw; blk < T / 16; blk += NGW) {
        const int row0 = blk * 16, b = row0 / SEQ;
        f32x4 gv[4], g2v[4];
#pragma unroll
        for (int i = 0; i < 4; ++i) { const int d = i * 256 + F.lane * 4; gv[i] = *(const f32x4*)(p.final_g + d); g2v[i] = *(const f32x4*)(mod + (size_t)((DEPTH - 1) * NB + b) * 6144 + 5120 + d); }
        const bf16_t* XB = (const bf16_t*)(p.ws + WS_XB);
        u32x2 nxb[4], ny0[4], ny1[4];
#pragma unroll
        for (int i = 0; i < 4; ++i) { const int d = i * 256 + F.lane * 4; const size_t row = (size_t)row0;
            nxb[i] = *(const u32x2*)(XB + row * D + d); ny0[i] = *(const u32x2*)(ybuf + (2 * row) * D + d); ny1[i] = *(const u32x2*)(ybuf + (2 * row + 1) * D + d); }
        for (int r = 0; r < 16; ++r) {
            const size_t row = (size_t)(row0 + r);
            f32x4 v[4]; u32x2 y0[4], y1[4]; float ss = 0.f;
#pragma unroll
            for (int i = 0; i < 4; ++i) { v[i] = (f32x4){bflo(nxb[i].x), bfhi(nxb[i].x), bflo(nxb[i].y), bfhi(nxb[i].y)}; y0[i] = ny0[i]; y1[i] = ny1[i]; }
            if (r + 1 < 16) {
#pragma unroll
                for (int i = 0; i < 4; ++i) { const int d = i * 256 + F.lane * 4; const size_t rn = row + 1;
                    nxb[i] = *(const u32x2*)(XB + rn * D + d); ny0[i] = *(const u32x2*)(ybuf + (2 * rn) * D + d); ny1[i] = *(const u32x2*)(ybuf + (2 * rn + 1) * D + d); } }
#pragma unroll
            for (int i = 0; i < 4; ++i) {
                f32x4 ys; ys[0] = bflo(y0[i].x) + bflo(y1[i].x); ys[1] = bfhi(y0[i].x) + bfhi(y1[i].x); ys[2] = bflo(y0[i].y) + bflo(y1[i].y); ys[3] = bfhi(y0[i].y) + bfhi(y1[i].y);
                v[i] = v[i] + g2v[i] * ys;
                ss += (v[i][0] * v[i][0] + v[i][1] * v[i][1]) + (v[i][2] * v[i][2] + v[i][3] * v[i][3]); }
            const float rstd = rsqrtf(wave_sum(ss) * (1.0f / D) + EPS);
#pragma unroll
            for (int i = 0; i < 4; ++i) { const int d = i * 256 + F.lane * 4; *(f32x4*)(p.out + row * D + d) = v[i] * rstd * gv[i]; }
        }
    }
}

constexpr int PH_PER_LAYER = 9, PH_TOTAL = 2 + DEPTH * PH_PER_LAYER;

__device__ __forceinline__ Params fresh_params() {
    Params r{};
#if defined(__HIP_DEVICE_COMPILE__)
    typedef const Params __attribute__((address_space(4))) KParams;
    KParams* q = (KParams*)__builtin_amdgcn_kernarg_segment_ptr(); asm volatile("" : "+s"(q));
    r.x = q->x; r.c = q->c; r.w_ada = q->w_ada; r.b_ada = q->b_ada; r.n1g = q->n1g; r.n2g = q->n2g; r.w_in = q->w_in; r.w_ret_o = q->w_ret_o; r.pool_w = q->pool_w; r.pool_scale = q->pool_scale;
    r.w_pool_o = q->w_pool_o; r.w_out = q->w_out; r.w_router = q->w_router; r.b_router = q->b_router; r.w_eg = q->w_eg; r.w_eu = q->w_eu; r.w_ed = q->w_ed; r.final_g = q->final_g;
    r.out = q->out; r.ws = q->ws; r.ph_lo = q->ph_lo; r.ph_hi = q->ph_hi;
#endif
    return r;
}
__global__ void __launch_bounds__(NTHR, 2) fwd_kernel(Params p0) {
    extern __shared__ __attribute__((aligned(16))) unsigned char lds_raw[];
    LAS unsigned char* const lds = (LAS unsigned char*)lds_raw;
    volatile LAS unsigned* bst = (volatile LAS unsigned*)(lds + LDS_BARW);
    if (threadIdx.x == 0) { bst[0] = 0u; bst[1] = 0u; bst[2] = 0u; bst[3] = 0u; }
    __syncthreads();
    XcdBarrier bar = xcd_barrier_post((unsigned*)(p0.ws + WS_CTL), bst);
    const int lo = p0.ph_lo, hi = p0.ph_hi;
#ifndef PHMASK
#define PHMASK 0xFFF
#endif
#define PSEL(j) ((PHMASK >> (j)) & 1)
#define IN(k) (lo <= (k) && (k) < hi)
#define SEAM(k) do { if (IN(k) && IN((k) + 1)) xcd_barrier(bar); } while (0)
#define PHASE_CTX() const Params p = fresh_params(); const Ctx F = make_ctx(lds); unsigned char* ws = p.ws; bf16_t* H = (bf16_t*)(ws + WS_H); \
    const int vcu = (F.G % 8 == 0) ? (F.bx % 8) * (F.G / 8) + F.bx / 8 : F.bx; (void)H; (void)vcu; (void)ws

    if (PSEL(10) && IN(0)) { PHASE_CTX(); phase_prologue(p, F); }
    SEAM(0);
    for (int l = 0; l < DEPTH; ++l) {
        const int pb = 1 + l * PH_PER_LAYER;
        if (PSEL(0) && IN(pb + 0)) { PHASE_CTX(); phase_norm1(p, F, l, NREP(12)); }
        SEAM(pb + 0);
        if (PSEL(1) && IN(pb + 1)) for (int rep = 0; rep < NREP(1); ++rep) { PHASE_CTX(); pg8::DenseOrder S; S.init(T, INW, F.G, F.bx, H, D, (const bf16_t*)(ws + WT_IN), D); S.wgm = 4;
            pg8::EpiProj E{ws, (const float*)(ws + WS_ROPE), (const float*)(ws + WS_ROPE) + SEQ * 64, (const float*)(ws + WS_DEC)};
            pg8::gemm_phase<pg8::EpiProj, pg8::DenseOrder>(F.lds, S, E, D, D, D); }
        SEAM(pb + 1);
        #ifdef USE_RET2
        if (PSEL(2) && IN(pb + 2)) { PHASE_CTX(); phase_ret2(p, F, vcu); }
#else
        if (PSEL(2) && IN(pb + 2)) { PHASE_CTX(); phase_ret3(p, F, vcu); }
#endif
        SEAM(pb + 2);
#ifdef USE_SUBUNITS
        if (PSEL(3) && IN(pb + 3)) for (int rep = 0; rep < NREP(3); ++rep) { PHASE_CTX(); pg8::HeadOrder S; S.d.init(T, D, F.G, F.bx, (const bf16_t*)(ws + WS_VB), 64, (const bf16_t*)(ws + WT_RO), D);
            pg8::EpiRet E{(const float*)(ws + WS_SSQ), ws + WS_GATE, (bf16_t*)(ws + WS_M1)};
            { pg8::DUnit tu; for (int i = 0; i < pg8::RTAB_MAXU && S.d.next(i, tu); ++i) E.fill_table(tu, i, F.tid, F.lds); __syncthreads(); }
            pg8::gemm_phase<pg8::EpiRet, pg8::HeadOrder>(F.lds, S, E, 256, 64, D, (size_t)SEQ * 64 * 2); }
#else
        if (PSEL(3) && IN(pb + 3)) for (int rep = 0; rep < NREP(3); ++rep) { PHASE_CTX(); pg8::RetOrder S; S.d.init(T, D, F.G, F.bx, (const bf16_t*)(ws + WS_VB), 64, (const bf16_t*)(ws + WT_RO), D);
            pg8::EpiRetK E{(const float*)(ws + WS_SSQ), ws + WS_GATE, (bf16_t*)(ws + WS_M1)};
            { pg8::DUnit tu; for (int i = 0; i < pg8::RTAB_MAXU && S.next(i, tu); ++i) E.fill_table(tu, i, F.tid, F.lds); __syncthreads(); }
            pg8::gemm_phase<pg8::EpiRetK, pg8::RetOrder>(F.lds, S, E, D, 64, D, (size_t)SEQ * 64 * 2); }
#endif
        { asm volatile("s_waitcnt vmcnt(0)" ::: "memory"); __syncthreads(); }
        if (PSEL(4) && IN(pb + 4)) for (int rep = 0; rep < NREP(4); ++rep) { PHASE_CTX(); pg8::DenseOrder S; S.init(T, D, F.G, F.bx, H, 512, (const bf16_t*)(ws + WT_PE), 512);
            pg8::EpiGate<true> E{ws + WS_GATE, 4, (const bf16_t*)(ws + WS_M1), D, (bf16_t*)(ws + WS_MRG), D};
            pg8::gemm_phase<pg8::EpiGate<true>, pg8::DenseOrder>(F.lds, S, E, 512, 512, 512); }
        SEAM(pb + 4);
        if (PSEL(5) && IN(pb + 5)) for (int rep = 0; rep < NREP(5); ++rep) { PHASE_CTX(); pg8::DenseOrder S; S.init(T, D, F.G, F.bx, (const bf16_t*)(ws + WS_MRG), D, (const bf16_t*)(ws + WT_OUT), D);
            if (l == 0) { pg8::EpiResid<true> E{p.x, nullptr, (bf16_t*)(ws + (rep + 1 < NREP(5) ? WS_SCR : WS_XB)), (const float*)(ws + WS_MOD) + 2048};
                pg8::gemm_phase<pg8::EpiResid<true>, pg8::DenseOrder>(F.lds, S, E, D, D, D); }
            else { pg8::EpiResid<false> E{nullptr, (const bf16_t*)(ws + WS_XB), (bf16_t*)(ws + (rep + 1 < NREP(5) ? WS_SCR : WS_XB)), (const float*)(ws + WS_MOD) + (size_t)l * NB * 6144 + 2048};
                pg8::gemm_phase<pg8::EpiResid<false>, pg8::DenseOrder>(F.lds, S, E, D, D, D); } }
        SEAM(pb + 5);
        if (PSEL(6) && IN(pb + 6)) for (int rep = 0; rep < NREP(6); ++rep) { PHASE_CTX(); phase_norm2_route(p, F, l, rep + 1 < NREP(6)); }
        SEAM(pb + 6);
        if (PSEL(7) && IN(pb + 7)) for (int rep = 0; rep < NREP(7); ++rep) {
            PHASE_CTX();
            LAS int* lc = (LAS int*)(F.lds + LDS_CNT);
            if (F.tid < 16) lc[F.tid] = (int)__hip_atomic_load((unsigned*)(ws + WS_CTL) + CW_CNT + l * 64 + F.tid, __ATOMIC_RELAXED, __HIP_MEMORY_SCOPE_AGENT);
            __syncthreads();
            pg8::MoeOrder<true> S; S.cnts = lc; S.G = F.G; S.c = vcu; S.A = (const char*)H; S.Bt = (const char*)(ws + WT_GU); S.atile = 0; S.bexp = (size_t)1024 * D * 2; S.btile = (size_t)256 * D * 2;
            S.stok = (const int*)(ws + WS_STOK); S.lda = D;
            pg8::EpiGateUp E{(bf16_t*)(ws + WS_ACT)};
            pg8::gemm_phase<pg8::EpiGateUp, pg8::MoeOrder<true>>(F.lds, S, E, D, D, D);
        }
        SEAM(pb + 7);
        if (PSEL(8) && IN(pb + 8)) for (int rep = 0; rep < NREP(8); ++rep) {
            PHASE_CTX();
            LAS int* lc = (LAS int*)(F.lds + LDS_CNT);
            if (F.tid < 16) lc[F.tid] = (int)__hip_atomic_load((unsigned*)(ws + WS_CTL) + CW_CNT + l * 64 + F.tid, __ATOMIC_RELAXED, __HIP_MEMORY_SCOPE_AGENT);
            __syncthreads();
            pg8::MoeOrder<false> S; S.cnts = lc; S.G = F.G; S.c = vcu; S.A = (const char*)(ws + WS_ACT); S.Bt = (const char*)(ws + WT_DN); S.atile = (size_t)256 * DE * 2; S.bexp = (size_t)D * DE * 2; S.btile = (size_t)256 * DE * 2;
            S.stok = (const int*)(ws + WS_STOK); S.lda = DE;
            pg8::EpiDown E{(bf16_t*)(ws + WS_YBUF), (const int*)(ws + WS_STOK), (const float*)(ws + WS_SW)};
            pg8::gemm_phase<pg8::EpiDown, pg8::MoeOrder<false>>(F.lds, S, E, DE, DE, DE);
        }
        SEAM(pb + 8);
    }
    if (PSEL(11) && IN(PH_TOTAL - 1)) { PHASE_CTX(); phase_final(p, F); }
#undef IN
#undef SEAM
}

extern "C" void kernel_launch(void* const* d_in, const int* in_sizes, int n_in, void* d_out, int out_size, void* d_ws, size_t ws_size, hipStream_t stream) {
    static int grid = 0;
    if (grid == 0) {
        if (n_in != 18 || in_sizes[0] != T * D || out_size != T * D || ws_size < WS_END) { fprintf(stderr, "kernel_launch: unexpected shapes / workspace (n_in %d, ws %zu)\n", n_in, ws_size); grid = -1; return; }
        int dev = 0, cus = 0, per_cu = 0;
        if (hipGetDevice(&dev) != hipSuccess || hipDeviceGetAttribute(&cus, hipDeviceAttributeMultiprocessorCount, dev) != hipSuccess) { grid = -1; return; }
        if (hipFuncSetAttribute((const void*)fwd_kernel, hipFuncAttributeMaxDynamicSharedMemorySize, LDS_BYTES) != hipSuccess) { fprintf(stderr, "kernel_launch: hipFuncSetAttribute failed\n"); grid = -1; return; }
        if (hipOccupancyMaxActiveBlocksPerMultiprocessor(&per_cu, (const void*)fwd_kernel, NTHR, LDS_BYTES) != hipSuccess || per_cu < 1) { fprintf(stderr, "kernel_launch: occupancy query says %d\n", per_cu); }
        (void)hipGetLastError();
        grid = cus;
    }
    if (grid < 0) return;
    if (hipMemsetAsync((char*)d_ws + WS_CTL, 0, CTL_ZERO_BYTES, stream) != hipSuccess) return;
    Params p{};
    p.x = (const float*)d_in[0]; p.c = (const float*)d_in[1]; p.w_ada = (const float*)d_in[2]; p.b_ada = (const float*)d_in[3]; p.n1g = (const float*)d_in[4]; p.n2g = (const float*)d_in[5];
    p.w_in = (const float*)d_in[6]; p.w_ret_o = (const float*)d_in[7]; p.pool_w = (const float*)d_in[8]; p.pool_scale = (const float*)d_in[9]; p.w_pool_o = (const float*)d_in[10]; p.w_out = (const float*)d_in[11];
    p.w_router = (const float*)d_in[12]; p.b_router = (const float*)d_in[13]; p.w_eg = (const float*)d_in[14]; p.w_eu = (const float*)d_in[15]; p.w_ed = (const float*)d_in[16]; p.final_g = (const float*)d_in[17];
    p.out = (float*)d_out; p.ws = (unsigned char*)d_ws; p.ph_lo = 0; p.ph_hi = PH_TOTAL;
    hipLaunchKernelGGL(fwd_kernel, dim3(grid), dim3(NTHR), LDS_BYTES, stream, p);
}
```

```cpp
#include <hip/hip_runtime.h>
#include <cstdio>
#include <cstdint>

#define LAS __attribute__((address_space(3)))
#ifndef REPMASK
#define REPMASK 0x000
#endif
#define NREP(j) (1 + ((REPMASK >> (j)) & 1))
typedef unsigned short bf16_t;
typedef short bf16x8 __attribute__((ext_vector_type(8)));
typedef float f32x4 __attribute__((ext_vector_type(4)));
typedef float f32x2 __attribute__((ext_vector_type(2)));
typedef unsigned u32x4 __attribute__((ext_vector_type(4)));
typedef unsigned u32x2 __attribute__((ext_vector_type(2)));

constexpr int NB = 16, SEQ = 2048, T = NB * SEQ, D = 1024, DEPTH = 4;
constexpr int INW = 5632, CQ = 0, CK = 512, CV = 1024, CG = 2048, CU = 3072, CAR = 3584, CAPL = 4608;
constexpr int NE = 16, DE = 512, CAP = 32768;
constexpr float EPS = 1e-6f;
constexpr int NWAVES = 8, NTHR = 512;

constexpr size_t MiB = 1u << 20;
constexpr size_t WS_CTL = 0, CTL_ZERO_BYTES = 65536;
constexpr size_t WS_MOD = 1 * MiB;
constexpr size_t WS_ROPE = 3 * MiB;
constexpr size_t WS_DEC = 2 * MiB + 512 * 1024;
constexpr size_t WS_STOK = 4 * MiB;
constexpr size_t WS_SW = 6 * MiB;
constexpr size_t WS_SSQ = 8 * MiB;
constexpr size_t WS_WL = 16 * MiB;
constexpr size_t WT_IN = WS_WL, WT_RO = WS_WL + 11 * MiB, WT_PE = WS_WL + 13 * MiB, WT_OUT = WS_WL + 14 * MiB, WT_GU = WS_WL + 16 * MiB, WT_DN = WS_WL + 48 * MiB;
constexpr size_t WS_H = 80 * MiB;
constexpr size_t WS_PROJ = 144 * MiB;
constexpr size_t WS_U = WS_PROJ;
constexpr size_t WS_M1 = WS_PROJ + 32 * MiB;
constexpr size_t WS_MRG = WS_PROJ + 96 * MiB;
constexpr size_t WS_ACT = WS_PROJ;
constexpr size_t WS_YBUF = WS_PROJ + 72 * MiB;
constexpr size_t WS_QB = 344 * MiB;
constexpr size_t WS_KB = 376 * MiB;
constexpr size_t WS_VB = 408 * MiB;
constexpr size_t WS_GB = 472 * MiB;
constexpr size_t WS_XB = 536 * MiB;
constexpr size_t WS_GATE = 600 * MiB;
constexpr size_t WS_SCR = WS_M1;
constexpr size_t WS_END = 664 * MiB;
constexpr int CW_FLAG = 8192;
constexpr int CW_CNT = 4096;

constexpr int LDS_BYTES = 163840;
constexpr int LDS_CNT = 131072 + 256;
constexpr int LDS_BARW = LDS_BYTES - 64;

__device__ __forceinline__ int rfl(int v) { return __builtin_amdgcn_readfirstlane(v); }
typedef __bf16 bf16x2_t __attribute__((ext_vector_type(2)));
__device__ __forceinline__ unsigned cvt_pk_bf16(float lo, float hi) { const f32x2 f = {lo, hi}; return __builtin_bit_cast(unsigned, __builtin_convertvector(f, bf16x2_t)); }
__device__ __forceinline__ bf16_t f2bf(float f) { return (bf16_t)(cvt_pk_bf16(f, 0.f) & 0xffffu); }
__device__ __forceinline__ float bf2f(bf16_t b) { return __uint_as_float(((unsigned)b) << 16); }
__device__ __forceinline__ float bflo(unsigned w) { return __uint_as_float(w << 16); }
__device__ __forceinline__ float bfhi(unsigned w) { return __uint_as_float(w & 0xffff0000u); }
__device__ __forceinline__ float wave_sum(float v) {
#pragma unroll
    for (int o = 1; o < 64; o <<= 1) v += __shfl_xor(v, o);
    return v;
}
__device__ __forceinline__ void unpack_u8x8(const u32x2 w, float (&o)[8]) {
    o[0] = (float)(w.x & 255u) * (1.0f / 255.0f); o[1] = (float)((w.x >> 8) & 255u) * (1.0f / 255.0f); o[2] = (float)((w.x >> 16) & 255u) * (1.0f / 255.0f); o[3] = (float)(w.x >> 24) * (1.0f / 255.0f);
    o[4] = (float)(w.y & 255u) * (1.0f / 255.0f); o[5] = (float)((w.y >> 8) & 255u) * (1.0f / 255.0f); o[6] = (float)((w.y >> 16) & 255u) * (1.0f / 255.0f); o[7] = (float)(w.y >> 24) * (1.0f / 255.0f);
}
__device__ __forceinline__ float sigmoid_f(float x) { return __builtin_amdgcn_rcpf(1.0f + __expf(-x)); }
__device__ __forceinline__ float silu_f(float x) { return x * sigmoid_f(x); }

#define XB_TMO      128
#define XB_XCNT(j)  (256  + 64 * (j))
#define XB_XSUB(j)  (1280 + 64 * (j))
#define XB_XGEN(j)  (2304 + 64 * (j))
#define XB_TOP      3328
#define XB_TOPGEN   3392
#define XCD_BAR_WORDS 3456
#define XB_SPIN_CAP (1u << 21)

__device__ __forceinline__ unsigned xb_ld(unsigned* p)              { return __hip_atomic_load(p, __ATOMIC_RELAXED, __HIP_MEMORY_SCOPE_AGENT); }
__device__ __forceinline__ unsigned xb_add(unsigned* p, unsigned v) { return __hip_atomic_fetch_add(p, v, __ATOMIC_RELAXED, __HIP_MEMORY_SCOPE_AGENT); }
__device__ __forceinline__ unsigned xb_xcc_id() { return (unsigned)__builtin_amdgcn_s_getreg((3 << 11) | 20) & 0xFu; }
#define XB_SPIN(cond, bar) do { unsigned _sp = 0; while (cond) { __builtin_amdgcn_s_sleep(1); \
    if ((++_sp & 255u) == 0u) { if (xb_ld(&(bar)[XB_TMO])) break; if (_sp > XB_SPIN_CAP) { atomicAdd(&(bar)[XB_TMO], 1u); break; } } } } while (0)

struct XcdBarrier { unsigned* bar; unsigned x; volatile LAS unsigned* st; };

__device__ __forceinline__ XcdBarrier xcd_barrier_post(unsigned* bar, volatile LAS unsigned* st) {
    XcdBarrier b; b.bar = bar; b.x = xb_xcc_id(); b.st = st;
    if (threadIdx.x == 0) (void)xb_add(&bar[XB_XCNT(b.x)], 1u);
    return b;
}
__device__ __forceinline__ void xcd_barrier_complete(unsigned* bar, unsigned x, unsigned& nloc, unsigned& nx) {
    const unsigned G = gridDim.x * gridDim.y * gridDim.z;
    unsigned sum, cnt, mine, sp = 0u;
    for (;;) {
        sum = 0u; cnt = 0u; mine = 0u;
#pragma unroll
        for (unsigned j = 0; j < 16; ++j) { const unsigned c = xb_ld(&bar[XB_XCNT(j)]); sum += c; cnt += (c > 0u) ? 1u : 0u; mine = (j == x) ? c : mine; }
        if (sum == G) break;
        __builtin_amdgcn_s_sleep(1);
        if ((++sp & 255u) == 0u) { if (xb_ld(&bar[XB_TMO])) break; if (sp > XB_SPIN_CAP) { atomicAdd(&bar[XB_TMO], 1u); break; } }
    }
    nloc = mine > 0u ? mine : 1u; nx = cnt > 0u ? cnt : 1u;
}
__device__ __forceinline__ void xcd_barrier(const XcdBarrier& b) {
    asm volatile("s_waitcnt vmcnt(0)" ::: "memory");
    __syncthreads();
    if (threadIdx.x == 0) {
        unsigned* bar = b.bar;
        __builtin_amdgcn_s_waitcnt(0);
        unsigned nloc = b.st[0], nx = b.st[1];
        if (nloc == 0u) { xcd_barrier_complete(bar, b.x, nloc, nx); b.st[0] = nloc; b.st[1] = nx; }
        const unsigned old = xb_add(&bar[XB_XSUB(b.x)], 1u);
        const unsigned gen = old / nloc;
        if (old + 1u == (gen + 1u) * nloc) {
            __builtin_amdgcn_fence(__ATOMIC_RELEASE, "agent");
            asm volatile("s_waitcnt vmcnt(0)" ::: "memory");
            const unsigned og = xb_add(&bar[XB_TOP], 1u);
            const unsigned tg = og / nx;
            if (og + 1u == (tg + 1u) * nx) xb_add(&bar[XB_TOPGEN], 1u);
            else XB_SPIN(xb_ld(&bar[XB_TOPGEN]) == tg, bar);
            __builtin_amdgcn_fence(__ATOMIC_ACQUIRE, "agent");
            xb_add(&bar[XB_XGEN(b.x)], 1u);
            asm volatile("s_waitcnt vmcnt(0)" ::: "memory");
        } else {
            XB_SPIN(xb_ld(&bar[XB_XGEN(b.x)]) == gen, bar);
            __builtin_amdgcn_fence(__ATOMIC_ACQUIRE, "agent");
            asm volatile("s_waitcnt vmcnt(0)" ::: "memory");
        }
    }
    __syncthreads();
}

__device__ __forceinline__ size_t gate_off(int pm, int gt, int ai, int m, int bj, int tid) { return ((size_t)((pm * 8 + gt) * 16 + (ai * 4 + m) * 2 + bj) * 512 + tid) * 8; }
__device__ __forceinline__ size_t m1_off(int pm, int pn, int ai, int m, int bj, int tid) { return ((size_t)((pm * 4 + pn) * 16 + (ai * 4 + m) * 2 + bj) * 512 + tid) * 16; }
namespace pg8 {
constexpr int BM = 256, BK = 64, HALF = 128, HTB = HALF * BK * 2, STAGE_BYTES = 8 * HTB, NXCD = 8, WGM = 8;
__host__ __device__ __forceinline__ int lds_byte(int r, int c) { const int st = (r >> 4) * 2 + (c >> 5), rr = r & 15, cc = c & 31, ob = rr * 64 + cc * 2; return st * 1024 + (ob ^ (((ob >> 9) & 1) << 5)); }
__host__ __device__ __forceinline__ void stage_rc(int b, int& R, int& C) { const int st = b / 1024, sb = b % 1024, swz = sb ^ (((sb >> 9) & 1) << 5); R = (st >> 1) * 16 + swz / 64; C = (st & 1) * 32 + (swz % 64) / 2; }
__host__ __device__ __forceinline__ int perm32(int rho) { const int n = rho >> 4, i = rho & 15; return 8 * (i >> 2) + 4 * n + (i & 3); }

struct DUnit { int pm, pn; };
struct DenseOrder {
    typedef DUnit Unit; static constexpr bool GATHER = false;
    int nM, nN, nwg, G, c; const char* A; const char* Bt; size_t atile, btile; int wgm = WGM;
    __device__ __forceinline__ void init(int M, int N, int G_, int c_, const bf16_t* A_, int lda, const bf16_t* Bt_, int K) {
        nM = M / BM; nN = N / BM; nwg = nM * nN; G = G_; c = c_; A = (const char*)A_; Bt = (const char*)Bt_; atile = (size_t)BM * lda * 2; btile = (size_t)BM * K * 2; }
    __device__ __forceinline__ bool next(int i, Unit& u) const {
        const long L = (long)i * G + c; if (L >= nwg) return false;
        int wgid = (int)L; { const int q = nwg / NXCD, r = nwg % NXCD, xcd = wgid % NXCD, off = wgid / NXCD; wgid = (xcd < r ? xcd * (q + 1) : r * (q + 1) + (xcd - r) * q) + off; }
        const int nig = wgm * nN, gid = wgid / nig, fm = gid * wgm, gsz = (nM - fm) < wgm ? (nM - fm) : wgm;
        u.pm = fm + ((wgid % nig) % gsz); u.pn = (wgid % nig) / gsz; return true;
    }
    __device__ __forceinline__ const char* a_ptr(const Unit& u) const { return A + (size_t)u.pm * atile; }
    __device__ __forceinline__ const char* b_ptr(const Unit& u) const { return Bt + (size_t)u.pn * btile; }
    __device__ __forceinline__ unsigned a_voff(const Unit&, int, int, int) const { return 0u; }
};
struct HUnit { int pm, pn, hh; };
struct HeadOrder {
    typedef HUnit Unit; static constexpr bool GATHER = false;
    DenseOrder d;
    __device__ __forceinline__ bool next(int i, Unit& u) const { DUnit t; if (!d.next(i >> 2, t)) return false; u.pm = t.pm; u.pn = t.pn; u.hh = i & 3; return true; }
    __device__ __forceinline__ const char* a_ptr(const Unit& u) const { return d.A + ((size_t)((((u.pm >> 3) * 4 + u.hh) * 4) * SEQ + (u.pm & 7) * BM)) * 128; }
    __device__ __forceinline__ const char* b_ptr(const Unit& u) const { return d.Bt + (size_t)u.pn * d.btile + u.hh * 512; }
    __device__ __forceinline__ unsigned a_voff(const Unit&, int, int, int) const { return 0u; }
};
struct RetOrder {
    typedef DUnit Unit; static constexpr bool GATHER = false;
    DenseOrder d;
    __device__ __forceinline__ bool next(int i, Unit& u) const { return d.next(i, u); }
    __device__ __forceinline__ const char* a_ptr(const Unit& u) const { return d.A + ((size_t)(((u.pm >> 3) * 16) * SEQ + (u.pm & 7) * BM)) * 128; }
    __device__ __forceinline__ const char* b_ptr(const Unit& u) const { return d.b_ptr(u); }
    __device__ __forceinline__ unsigned a_voff(const Unit&, int, int, int) const { return 0u; }
};
struct MUnit { int pm, pn, e, pos0, cnt, L; };
template <bool GATHER_>
struct MoeOrder {
    typedef MUnit Unit; static constexpr bool GATHER = GATHER_;
    const LAS int* cnts; int G, c; const char* A; const char* Bt; size_t atile, bexp, btile; const int* stok; int lda;
    int base = 0, limit = 0x7fffffff;
    int nfull = 0x7fffffff, rank = 0, nrest = 1;
    int dep_from = 0x7fffffff; unsigned* dep_flag = nullptr; unsigned dep_need = 0;
    __device__ __forceinline__ bool is_dep(const Unit& u) const { return u.L >= dep_from; }
    __device__ __forceinline__ void wait_dep() const {
        if (threadIdx.x == 0) { unsigned sp = 0u; while (xb_ld(dep_flag) < dep_need) { __builtin_amdgcn_s_sleep(2); if (++sp > XB_SPIN_CAP) break; }
            __builtin_amdgcn_fence(__ATOMIC_ACQUIRE, "agent"); asm volatile("s_waitcnt vmcnt(0)" ::: "memory"); }
        __syncthreads();
    }
    __device__ __forceinline__ bool next(int i, Unit& u) const {
        int L = base + i * G + c;
        if (i >= nfull) { if (rank < 0) return false; L = nfull * G + (i - nfull) * nrest + rank; }
        if (L >= limit) return false; u.L = L; const int mt = L >> 2;
        int acc = 0, fe = -1, fpos = 0, fcnt = 0;
#pragma unroll
        for (int e = 0; e < NE; ++e) { const int ce = cnts[e]; const int te = (ce + 255) >> 8; if (mt >= acc && mt < acc + te) { fe = e; fpos = (mt - acc) << 8; fcnt = ce; } acc += te; }
        fe = rfl(fe); if (fe < 0) return false;
        u.pm = mt; u.pn = L & 3; u.e = fe; u.pos0 = rfl(fpos); u.cnt = rfl(fcnt); return true;
    }
    __device__ __forceinline__ const char* a_ptr(const Unit& u) const { return GATHER ? A : A + (size_t)u.pm * atile; }
    __device__ __forceinline__ const char* b_ptr(const Unit& u) const { return Bt + (size_t)u.e * bexp + (size_t)u.pn * btile; }
    __device__ __forceinline__ unsigned a_voff(const Unit& u, int h, int R, int C) const {
        int pos = u.pos0 + h * HALF + R; pos = pos < u.cnt ? pos : u.cnt - 1;
        const int tok = stok[(size_t)u.e * CAP + pos] >> 1;
        return (unsigned)(tok * lda + C) * 2u;
    }
};

template <class S, class = void> struct has_dep { static constexpr bool v = false; };
template <class S> struct has_dep<S, decltype((void)&S::wait_dep)> { static constexpr bool v = true; };
template <class E, class = void> struct wants_ui { static constexpr bool v = false; };
template <class E> struct wants_ui<E, decltype((void)E::WANTS_UI)> { static constexpr bool v = E::WANTS_UI; };
template <class E, class = void> struct has_khook { static constexpr bool v = false; };
template <class E> struct has_khook<E, decltype((void)E::KHOOK)> { static constexpr bool v = E::KHOOK; };
template <class Epi, class Sched>
__device__ __forceinline__ void gemm_phase(LAS unsigned char* lds, const Sched& S, const Epi& E, const int K, const int lda, const int ldb, const size_t kstepA = 128) {
    typedef typename Sched::Unit Unit;
    int tid = threadIdx.x; asm volatile("" : "+v"(tid));
    const int wid = rfl(tid >> 6), lane = tid & 63, wr = wid >> 2, wc = wid & 3, fr = lane & 15, fq = lane >> 4;
    const int nt = K / BK;
    int Rr[2], Cc[2]; unsigned voffB[2];
#pragma unroll
    for (int i = 0; i < 2; ++i) { int R, C; stage_rc(tid * 16 + i * 8192, R, C); Rr[i] = R; Cc[i] = C; const int Rb = Epi::PERM ? ((R & ~31) + perm32(R & 31)) : R; voffB[i] = (unsigned)(Rb * ldb + C) * 2u; }
    const size_t kstep = (size_t)(BK * 2);
    const size_t hstepB = (size_t)HALF * ldb * 2;
    const unsigned ldsw = (unsigned)wid * 1024u;
    const int aoff = lds_byte(wr * 64 + fr, fq * 8), boff = lds_byte(wc * 32 + fr, fq * 8);
#define PG8_SA(b, h) (((b) * 2 + (h)) * HTB)
#define PG8_SB(b, h) ((4 + (b) * 2 + (h)) * HTB)
#define PG8_STAGE(bufoff, gbase, voff) do { _Pragma("unroll") for (int _i = 0; _i < 2; ++_i) \
        __builtin_amdgcn_global_load_lds((const unsigned*)((const char*)(gbase) + (voff)[_i]), (LAS unsigned*)(lds + (bufoff) + ldsw + _i * 8192), 16, 0, 0); } while (0)
#define PG8_LDA(dst, b, h) do { _Pragma("unroll") for (int m = 0; m < 4; ++m) _Pragma("unroll") for (int k = 0; k < 2; ++k) dst[m][k] = *(const LAS bf16x8*)(lds + PG8_SA(b, h) + aoff + m * 2048 + k * 1024); } while (0)
#define PG8_LDB(dst, b, h) do { _Pragma("unroll") for (int n = 0; n < 2; ++n) _Pragma("unroll") for (int k = 0; k < 2; ++k) dst[n][k] = *(const LAS bf16x8*)(lds + PG8_SB(b, h) + boff + n * 2048 + k * 1024); } while (0)
#define PG8_MMA(ai, bj, At, Bt) do { __builtin_amdgcn_s_setprio(1); _Pragma("unroll") for (int m = 0; m < 4; ++m) _Pragma("unroll") for (int n = 0; n < 2; ++n) _Pragma("unroll") for (int k = 0; k < 2; ++k) \
        acc[ai][bj][m][n] = __builtin_amdgcn_mfma_f32_16x16x32_bf16(Bt[n][k], At[m][k], acc[ai][bj][m][n], 0, 0, 0); __builtin_amdgcn_s_setprio(0); } while (0)
#define PG8_WAIT_V(n) asm volatile("s_waitcnt vmcnt(" #n ")" ::: "memory")
#define PG8_WAIT_L(n) asm volatile("s_waitcnt lgkmcnt(" #n ")" ::: "memory")
#define PG8_BAR __builtin_amdgcn_s_barrier()
#define PG8_SCHED __builtin_amdgcn_sched_barrier(0)
    Unit cur, nxt; int ui = 0;
    if (!S.next(0, cur)) return;
    if constexpr (has_dep<Sched>::v) { if (S.is_dep(cur)) S.wait_dep(); }
    unsigned vAc[2][2], vAn[2][2];
#pragma unroll
    for (int h = 0; h < 2; ++h)
#pragma unroll
        for (int i = 0; i < 2; ++i) { vAc[h][i] = Sched::GATHER ? S.a_voff(cur, h, Rr[i], Cc[i]) : (unsigned)((h * HALF + Rr[i]) * lda + Cc[i]) * 2u; vAn[h][i] = vAc[h][i]; }
    f32x4 acc[2][2][4][2];
#pragma unroll
    for (int a = 0; a < 2; ++a)
#pragma unroll
        for (int b = 0; b < 2; ++b)
#pragma unroll
            for (int m = 0; m < 4; ++m)
#pragma unroll
                for (int n = 0; n < 2; ++n) acc[a][b][m][n] = (f32x4){0.f, 0.f, 0.f, 0.f};
    bf16x8 At[4][2], B0[2][2], B1[2][2];
    const char* cA = S.a_ptr(cur); const char* cB = S.b_ptr(cur);
    PG8_STAGE(PG8_SB(0, 0), cB, voffB); PG8_STAGE(PG8_SB(0, 1), cB + hstepB, voffB); PG8_STAGE(PG8_SA(0, 0), cA, vAc[0]); PG8_STAGE(PG8_SA(0, 1), cA, vAc[1]);
    if (wr == 1) PG8_BAR;
    PG8_WAIT_V(2); PG8_BAR;
    PG8_STAGE(PG8_SB(1, 0), cB + kstep, voffB); PG8_STAGE(PG8_SA(1, 0), cA + kstepA, vAc[0]); PG8_STAGE(PG8_SB(1, 1), cB + hstepB + kstep, voffB);
    PG8_WAIT_V(6); PG8_BAR;
    for (;;) {
        const bool has_next = S.next(ui + 1, nxt);
        if constexpr (has_dep<Sched>::v) { if (has_next && S.is_dep(nxt)) S.wait_dep(); }
        const char* nA = has_next ? S.a_ptr(nxt) : cA; const char* nB = has_next ? S.b_ptr(nxt) : cB;
        if constexpr (Sched::GATHER) {
            if (has_next) {
#pragma unroll
                for (int h = 0; h < 2; ++h)
#pragma unroll
                    for (int i = 0; i < 2; ++i) vAn[h][i] = S.a_voff(nxt, h, Rr[i], Cc[i]);
            }
        }
        for (int t = 0; t < nt; t += 2) {
            const bool last = (t == nt - 2);
            if constexpr (has_khook<Epi>::v) { if (t != 0 && (t & 3) == 0) E.khook(acc, ui, t, wr, fr, lds); }
            size_t tk = (size_t)t * kstep; asm volatile("" : "+s"(tk));
            size_t tkA = (size_t)t * kstepA; asm volatile("" : "+s"(tkA));
            const char* a1 = cA + tkA + kstepA;
            const char* a2 = last ? nA : cA + tkA + 2 * kstepA; const char* b2 = last ? nB : cB + tk + 2 * kstep;
            const char* a3 = a2 + kstepA; const char* b3 = b2 + kstep;
            unsigned s0[2], s1[2];
#pragma unroll
            for (int i = 0; i < 2; ++i) { s0[i] = (Sched::GATHER && last) ? vAn[0][i] : vAc[0][i]; s1[i] = (Sched::GATHER && last) ? vAn[1][i] : vAc[1][i]; }
            PG8_LDB(B0, 0, 0); PG8_LDB(B1, 0, 1); PG8_SCHED; PG8_LDA(At, 0, 0); PG8_STAGE(PG8_SA(1, 1), a1, vAc[1]);
            PG8_WAIT_V(8); PG8_WAIT_L(0); PG8_BAR; PG8_MMA(0, 0, At, B0); PG8_MMA(0, 1, At, B1); PG8_BAR; PG8_SCHED;
            PG8_LDA(At, 0, 1); PG8_STAGE(PG8_SB(0, 0), b2, voffB); PG8_STAGE(PG8_SB(0, 1), b2 + hstepB, voffB); PG8_STAGE(PG8_SA(0, 0), a2, s0);
            PG8_WAIT_V(8); PG8_WAIT_L(0); PG8_BAR; PG8_MMA(1, 0, At, B0); PG8_MMA(1, 1, At, B1); PG8_BAR; PG8_SCHED;
            PG8_LDB(B0, 1, 0); PG8_LDB(B1, 1, 1); PG8_SCHED; PG8_LDA(At, 1, 0); PG8_STAGE(PG8_SA(0, 1), a2, s1);
            PG8_WAIT_V(8); PG8_WAIT_L(0); PG8_BAR; PG8_MMA(0, 0, At, B0); PG8_MMA(0, 1, At, B1); PG8_BAR; PG8_SCHED;
            PG8_LDA(At, 1, 1); PG8_STAGE(PG8_SB(1, 0), b3, voffB); PG8_STAGE(PG8_SB(1, 1), b3 + hstepB, voffB); PG8_STAGE(PG8_SA(1, 0), a3, s0);
            PG8_WAIT_V(8); PG8_WAIT_L(0); PG8_BAR; PG8_MMA(1, 0, At, B0); PG8_MMA(1, 1, At, B1); PG8_BAR; PG8_SCHED;
        }
        if (wr == 0) PG8_BAR;
        bool keep = false;
        if constexpr (Epi::SUBUNITS) keep = E.sub(acc, cur, ui, wr, wc, fr, fq, lds); else if constexpr (has_khook<Epi>::v || wants_ui<Epi>::v) E.fin(acc, cur, ui, wr, wc, fr, fq, lds); else E(acc, cur, wr, wc, fr, fq);
        if (!has_next) break;
        if (!keep) {
        float zz = 0.f; if constexpr (Epi::SUBUNITS) asm volatile("" : "+v"(zz));
#pragma unroll
        for (int a = 0; a < 2; ++a)
#pragma unroll
            for (int b = 0; b < 2; ++b)
#pragma unroll
                for (int m = 0; m < 4; ++m)
#pragma unroll
                    for (int n = 0; n < 2; ++n) acc[a][b][m][n] = (f32x4){zz, zz, zz, zz};
        }
        cur = nxt; cA = nA; cB = nB; ++ui;
        if constexpr (Sched::GATHER) {
#pragma unroll
            for (int h = 0; h < 2; ++h)
#pragma unroll
                for (int i = 0; i < 2; ++i) vAc[h][i] = vAn[h][i];
        }
        if (wr == 1) PG8_BAR;
    }
    PG8_WAIT_V(0);
    PG8_BAR;
#undef PG8_SA
#undef PG8_SB
#undef PG8_STAGE
#undef PG8_LDA
#undef PG8_LDB
#undef PG8_MMA
#undef PG8_WAIT_V
#undef PG8_WAIT_L
#undef PG8_BAR
#undef PG8_SCHED
}

struct EpiStore {
    static constexpr bool PERM = true, SUBUNITS = false;
    bf16_t* O; int ldc;
    __device__ __forceinline__ void operator()(const f32x4 (&acc)[2][2][4][2], const DUnit& u, int wr, int wc, int fr, int fq) const {
        const int row0 = u.pm * BM + wr * 64 + fr, col0 = u.pn * BM + wc * 32 + 8 * fq;
#pragma unroll
        for (int ai = 0; ai < 2; ++ai)
#pragma unroll
            for (int m = 0; m < 4; ++m) { bf16_t* rowp = O + (size_t)(row0 + ai * HALF + m * 16) * ldc + col0;
#pragma unroll
                for (int bj = 0; bj < 2; ++bj) { const f32x4 v0 = acc[ai][bj][m][0], v1 = acc[ai][bj][m][1];
                    u32x4 w; w.x = cvt_pk_bf16(v0[0], v0[1]); w.y = cvt_pk_bf16(v0[2], v0[3]); w.z = cvt_pk_bf16(v1[0], v1[1]); w.w = cvt_pk_bf16(v1[2], v1[3]);
                    *(u32x4*)(rowp + bj * HALF) = w; } }
    }
};
struct EpiProj {
    static constexpr bool PERM = true, SUBUNITS = false, PROBE2 = false;
    unsigned char* ws; const float* cosT; const float* sinT; const float* dec;
    __device__ __forceinline__ void operator()(const f32x4 (&acc)[2][2][4][2], const DUnit& u, int wr, int wc, int fr, int fq) const {
        const int b = u.pm >> 3, pos0 = (u.pm & 7) * BM + wr * 64 + fr;
        if (u.pn < 4) {
            const int i0 = 16 * wc + 4 * fq;
            const float* dtab = dec + (u.pn >> 1) * (4 * SEQ) + (2 * (u.pn & 1)) * SEQ;
            bf16_t* base = (bf16_t*)(ws + (u.pn < 2 ? WS_QB : WS_KB));
#pragma unroll
            for (int ai = 0; ai < 2; ++ai) {
                f32x4 c4[4], s4[4]; float dsc[4][2];
#pragma unroll
                for (int m = 0; m < 4; ++m) { const int pos = pos0 + ai * HALF + m * 16;
                    c4[m] = *(const f32x4*)(cosT + pos * 64 + i0); s4[m] = *(const f32x4*)(sinT + pos * 64 + i0); dsc[m][0] = dtab[pos]; dsc[m][1] = dtab[SEQ + pos]; }
#pragma unroll
                for (int m = 0; m < 4; ++m) { const int pos = pos0 + ai * HALF + m * 16;
#pragma unroll
                    for (int bj = 0; bj < 2; ++bj) { const f32x4 t1 = acc[ai][bj][m][0], t2 = acc[ai][bj][m][1];
                        const f32x4 o1 = (t1 * c4[m] - t2 * s4[m]) * dsc[m][bj], o2 = (t1 * s4[m] + t2 * c4[m]) * dsc[m][bj];
                        bf16_t* dst = base + ((size_t)((b * 4 + 2 * (u.pn & 1) + bj) * SEQ + pos)) * 128 + i0;
                        u32x2 w1, w2; w1.x = cvt_pk_bf16(o1[0], o1[1]); w1.y = cvt_pk_bf16(o1[2], o1[3]); w2.x = cvt_pk_bf16(o2[0], o2[1]); w2.y = cvt_pk_bf16(o2[2], o2[3]);
                        *(u32x2*)dst = w1; *(u32x2*)(dst + 64) = w2; } }
            }
        } else if (u.pn < 12) {
            bf16_t* base = (bf16_t*)(ws + (u.pn < 8 ? WS_VB : WS_GB)); const int head = (u.pn - 4) & 3; const int e0 = 32 * (wc & 1) + 8 * fq;
#pragma unroll
            for (int ai = 0; ai < 2; ++ai)
#pragma unroll
                for (int m = 0; m < 4; ++m) { const int pos = pos0 + ai * HALF + m * 16;
#pragma unroll
                    for (int bj = 0; bj < 2; ++bj) { const f32x4 v0 = acc[ai][bj][m][0], v1 = acc[ai][bj][m][1];
                        u32x4 w; w.x = cvt_pk_bf16(v0[0], v0[1]); w.y = cvt_pk_bf16(v0[2], v0[3]); w.z = cvt_pk_bf16(v1[0], v1[1]); w.w = cvt_pk_bf16(v1[2], v1[3]);
                        *(u32x4*)(base + ((size_t)(((b * 4 + head) * 4 + 2 * bj + (wc >> 1)) * SEQ + pos)) * 64 + e0) = w; } }
        } else if (u.pn >= 14) {
            unsigned char* GA = ws + WS_GATE;
            const int col0 = (u.pn - 14) * BM + wc * 32 + 8 * fq;
#pragma unroll
            for (int ai = 0; ai < 2; ++ai)
#pragma unroll
                for (int m = 0; m < 4; ++m) {
#pragma unroll
                    for (int bj = 0; bj < 2; ++bj) { const f32x4 v0 = acc[ai][bj][m][0], v1 = acc[ai][bj][m][1];
                        unsigned q[8];
#pragma unroll
                        for (int k = 0; k < 4; ++k) { q[k] = (unsigned)(sigmoid_f(v0[k]) * 255.0f + 0.5f); q[4 + k] = (unsigned)(sigmoid_f(v1[k]) * 255.0f + 0.5f); }
                        u32x2 w; w.x = q[0] | (q[1] << 8) | (q[2] << 16) | (q[3] << 24); w.y = q[4] | (q[5] << 8) | (q[6] << 16) | (q[7] << 24);
                        *(u32x2*)(GA + gate_off(u.pm, u.pn - 14, ai, m, bj, wr * 256 + wc * 64 + fq * 16 + fr)) = w; } }
        } else {
            bf16_t* U = (bf16_t*)(ws + WS_U);
            const int col0 = (u.pn - 12) * BM + wc * 32 + 8 * fq;
#pragma unroll
            for (int ai = 0; ai < 2; ++ai)
#pragma unroll
                for (int m = 0; m < 4; ++m) { bf16_t* rowp = U + (size_t)(b * SEQ + pos0 + ai * HALF + m * 16) * 512 + col0;
#pragma unroll
                    for (int bj = 0; bj < 2; ++bj) { const f32x4 v0 = acc[ai][bj][m][0], v1 = acc[ai][bj][m][1];
                        u32x4 w; w.x = cvt_pk_bf16(v0[0], v0[1]); w.y = cvt_pk_bf16(v0[2], v0[3]); w.z = cvt_pk_bf16(v1[0], v1[1]); w.w = cvt_pk_bf16(v1[2], v1[3]);
                        *(u32x4*)(rowp + bj * HALF) = w; } }
        }
    }
};
constexpr int LDS_RTAB = 131072 + 512, RTAB_MAXU = 6;
struct EpiRet {
    static constexpr bool PERM = true, SUBUNITS = true;
    const float* ssq; const unsigned char* gate; bf16_t* O;
    __device__ __forceinline__ void fill_table(const DUnit& u, int ti, int tid, LAS unsigned char* lds) const {
        if (tid < 256) { const float* sp = ssq + (size_t)(u.pm * BM + tid) * 16; float rs[4];
#pragma unroll
            for (int h = 0; h < 4; ++h) { const f32x4 s4 = *(const f32x4*)(sp + 4 * h); rs[h] = rsqrtf(((s4[0] + s4[1]) + (s4[2] + s4[3])) * (1.0f / 256.0f) + EPS); }
            *(LAS f32x4*)(lds + LDS_RTAB + ti * 4096 + tid * 16) = (f32x4){rs[0] / rs[1], rs[1] / rs[2], rs[2] / rs[3], rs[3]}; }
    }
    __device__ __forceinline__ bool sub(f32x4 (&acc)[2][2][4][2], const HUnit& u, int ui, int wr, int wc, int fr, int fq, LAS unsigned char* lds) const {
        unsigned tb = (unsigned)(LDS_RTAB + (ui >> 2) * 4096 + (wr * 64 + fr) * 16 + u.hh * 4); asm volatile("" : "+v"(tb));
        if (u.hh < 3) {
#pragma unroll
            for (int ai = 0; ai < 2; ++ai)
#pragma unroll
                for (int m = 0; m < 4; ++m) { const float r = *(const LAS float*)(lds + tb + (ai * HALF + m * 16) * 16);
#pragma unroll
                    for (int bj = 0; bj < 2; ++bj)
#pragma unroll
                        for (int n = 0; n < 2; ++n) acc[ai][bj][m][n] = acc[ai][bj][m][n] * r; }
            return true;
        }
        const int col0 = u.pn * BM + wc * 32 + 8 * fq;
#pragma unroll
        for (int ai = 0; ai < 2; ++ai) {
            u32x2 gva[4][2];
#pragma unroll
            for (int m = 0; m < 4; ++m)
#pragma unroll
                for (int bj = 0; bj < 2; ++bj) gva[m][bj] = *(const u32x2*)(gate + gate_off(u.pm, u.pn, ai, m, bj, wr * 256 + wc * 64 + fq * 16 + fr));
#pragma unroll
            for (int m = 0; m < 4; ++m) { const int rl = ai * HALF + wr * 64 + m * 16 + fr; const float r = *(const LAS float*)(lds + tb + (ai * HALF + m * 16) * 16); const size_t row = (size_t)(u.pm * BM + rl);
#pragma unroll
                for (int bj = 0; bj < 2; ++bj) { const int col = col0 + bj * HALF;
                    float sg[8]; unpack_u8x8(gva[m][bj], sg);
                    const f32x4 v0 = acc[ai][bj][m][0] * r, v1 = acc[ai][bj][m][1] * r;
                    u32x4 w;
                    w.x = cvt_pk_bf16(sg[0] * v0[0], sg[1] * v0[1]); w.y = cvt_pk_bf16(sg[2] * v0[2], sg[3] * v0[3]);
                    w.z = cvt_pk_bf16(sg[4] * v1[0], sg[5] * v1[1]); w.w = cvt_pk_bf16(sg[6] * v1[2], sg[7] * v1[3]);
                    *(u32x4*)((unsigned char*)O + m1_off(u.pm, u.pn, ai, m, bj, wr * 256 + wc * 64 + fq * 16 + fr)) = w; } }
        }
        return false;
    }
};
struct EpiRetK {
    static constexpr bool PERM = true, SUBUNITS = false, KHOOK = true;
    const float* ssq; const unsigned char* gate; bf16_t* O;
    __device__ __forceinline__ void fill_table(const DUnit& u, int ti, int tid, LAS unsigned char* lds) const {
        if (tid < 256) { const float* sp = ssq + (size_t)(u.pm * BM + tid) * 16; float rs[4];
#pragma unroll
            for (int h = 0; h < 4; ++h) { const f32x4 s4 = *(const f32x4*)(sp + 4 * h); rs[h] = rsqrtf(((s4[0] + s4[1]) + (s4[2] + s4[3])) * (1.0f / 256.0f) + EPS); }
            *(LAS f32x4*)(lds + LDS_RTAB + ti * 4096 + tid * 16) = (f32x4){rs[0] / rs[1], rs[1] / rs[2], rs[2] / rs[3], rs[3]}; }
    }
    __device__ __forceinline__ void khook(f32x4 (&acc)[2][2][4][2], int ui, int t, int, int, LAS unsigned char* lds) const {
        int tid = threadIdx.x; asm volatile("" : "+v"(tid));
        const int wr = tid >> 8, fr = tid & 15;
        unsigned tb = (unsigned)(LDS_RTAB + ui * 4096 + (wr * 64 + fr) * 16 + ((t >> 2) - 1) * 4); asm volatile("" : "+v"(tb));
#pragma unroll
        for (int ai = 0; ai < 2; ++ai)
#pragma unroll
            for (int m = 0; m < 4; ++m) { const float r = *(const LAS float*)(lds + tb + (ai * HALF + m * 16) * 16);
#pragma unroll
                for (int bj = 0; bj < 2; ++bj)
#pragma unroll
                    for (int n = 0; n < 2; ++n) acc[ai][bj][m][n] = acc[ai][bj][m][n] * r; }
    }
    __device__ __forceinline__ void operator()(const f32x4 (&acc)[2][2][4][2], const DUnit& u, int wr, int wc, int fr, int fq) const { }
    __device__ __forceinline__ void fin(const f32x4 (&acc)[2][2][4][2], const DUnit& u, int ui, int, int, int, int, LAS unsigned char* lds) const {
        int tid = threadIdx.x; asm volatile("" : "+v"(tid));
        const int wr = tid >> 8, wc = (tid >> 6) & 3, fr = tid & 15, fq = (tid & 63) >> 4;
        unsigned tb = (unsigned)(LDS_RTAB + ui * 4096 + (wr * 64 + fr) * 16 + 12); asm volatile("" : "+v"(tb));
        const int col0 = u.pn * BM + wc * 32 + 8 * fq;
        u32x2 gva[2][4][2];
#pragma unroll
        for (int ai = 0; ai < 2; ++ai)
#pragma unroll
            for (int m = 0; m < 4; ++m)
#pragma unroll
                for (int bj = 0; bj < 2; ++bj) gva[ai][m][bj] = *(const u32x2*)(gate + gate_off(u.pm, u.pn, ai, m, bj, wr * 256 + wc * 64 + fq * 16 + fr));
#pragma unroll
        for (int ai = 0; ai < 2; ++ai) {
#pragma unroll
            for (int m = 0; m < 4; ++m) { const float r = *(const LAS float*)(lds + tb + (ai * HALF + m * 16) * 16);
#pragma unroll
                for (int bj = 0; bj < 2; ++bj) {
                    float sg[8]; unpack_u8x8(gva[ai][m][bj], sg);
                    const f32x4 v0 = acc[ai][bj][m][0] * r, v1 = acc[ai][bj][m][1] * r;
                    u32x4 w;
                    w.x = cvt_pk_bf16(sg[0] * v0[0], sg[1] * v0[1]); w.y = cvt_pk_bf16(sg[2] * v0[2], sg[3] * v0[3]);
                    w.z = cvt_pk_bf16(sg[4] * v1[0], sg[5] * v1[1]); w.w = cvt_pk_bf16(sg[6] * v1[2], sg[7] * v1[3]);
                    *(u32x4*)((unsigned char*)O + m1_off(u.pm, u.pn, ai, m, bj, wr * 256 + wc * 64 + fq * 16 + fr)) = w; } }
        }
    }
};
template <bool ADD>
struct EpiGate {
    static constexpr bool PERM = true, SUBUNITS = false;
    const unsigned char* gate; int ldg; const bf16_t* base; int ldb; bf16_t* O; int ldc;
    __device__ __forceinline__ void operator()(const f32x4 (&acc)[2][2][4][2], const DUnit& u, int wr, int wc, int fr, int fq) const {
        const int row0 = u.pm * BM + wr * 64 + fr, col0 = u.pn * BM + wc * 32 + 8 * fq;
        const int tidx = wr * 256 + wc * 64 + fq * 16 + fr;
        u32x2 gq[2][2][2]; u32x4 bq[2][2][2];
#define GATE_LOAD(slot, q) do { _Pragma("unroll") for (int mi = 0; mi < 2; ++mi) _Pragma("unroll") for (int bj = 0; bj < 2; ++bj) { const int m_ = 2 * ((q) & 1) + mi; \
            gq[slot][mi][bj] = *(const u32x2*)(gate + gate_off(u.pm, ldg + u.pn, (q) >> 1, m_, bj, tidx)); bq[slot][mi][bj] = (u32x4){0u, 0u, 0u, 0u}; \
            if (ADD) bq[slot][mi][bj] = *(const u32x4*)((const unsigned char*)base + m1_off(u.pm, u.pn, (q) >> 1, m_, bj, tidx)); } } while (0)
        GATE_LOAD(0, 0);
#pragma unroll
        for (int q = 0; q < 4; ++q) { const int sl = q & 1, ai = q >> 1;
            if (q + 1 < 4) GATE_LOAD((q + 1) & 1, q + 1);
#pragma unroll
            for (int mi = 0; mi < 2; ++mi)
#pragma unroll
                for (int bj = 0; bj < 2; ++bj) { const int m = 2 * (q & 1) + mi; const size_t row = (size_t)(row0 + ai * HALF + m * 16); const int col = col0 + bj * HALF;
                    const u32x4 bb = bq[sl][mi][bj]; float sg[8]; unpack_u8x8(gq[sl][mi][bj], sg);
                    const f32x4 v0 = acc[ai][bj][m][0], v1 = acc[ai][bj][m][1];
                    float o[8];
                    o[0] = sg[0] * v0[0]; o[1] = sg[1] * v0[1]; o[2] = sg[2] * v0[2]; o[3] = sg[3] * v0[3];
                    o[4] = sg[4] * v1[0]; o[5] = sg[5] * v1[1]; o[6] = sg[6] * v1[2]; o[7] = sg[7] * v1[3];
                    if (ADD) { o[0] += bflo(bb.x); o[1] += bfhi(bb.x); o[2] += bflo(bb.y); o[3] += bfhi(bb.y); o[4] += bflo(bb.z); o[5] += bfhi(bb.z); o[6] += bflo(bb.w); o[7] += bfhi(bb.w); }
                    u32x4 w; w.x = cvt_pk_bf16(o[0], o[1]); w.y = cvt_pk_bf16(o[2], o[3]); w.z = cvt_pk_bf16(o[4], o[5]); w.w = cvt_pk_bf16(o[6], o[7]);
                    *(u32x4*)(O + row * ldc + col) = w; }
        }
#undef GATE_LOAD
    }
};
template <bool F32IN>
struct EpiResid {
    static constexpr bool PERM = true, SUBUNITS = false, PROBE2 = false;
    const float* xin32; const bf16_t* xin16; bf16_t* xout; const float* gvec;
    __device__ __forceinline__ void operator()(const f32x4 (&acc)[2][2][4][2], const DUnit& u, int wr, int wc, int fr, int fq) const {
        { int tid_ = threadIdx.x; asm volatile("" : "+v"(tid_)); wr = tid_ >> 8; wc = (tid_ >> 6) & 3; fr = tid_ & 15; fq = (tid_ & 63) >> 4; }
        const int row0 = u.pm * BM + wr * 64 + fr, col0 = u.pn * BM + wc * 32 + 8 * fq;
        const float* gp = gvec + (size_t)(u.pm >> 3) * 6144 + col0;
        f32x4 gv[2][2];
#pragma unroll
        for (int bj = 0; bj < 2; ++bj)
#pragma unroll
            for (int n = 0; n < 2; ++n) gv[bj][n] = *(const f32x4*)(gp + bj * HALF + n * 4);
        u32x4 rb[2][2][2]; f32x4 rf[2][2][2][2];
#define RESID_LOAD(slot, q) do { _Pragma("unroll") for (int mi = 0; mi < 2; ++mi) _Pragma("unroll") for (int bj = 0; bj < 2; ++bj) { \
            const size_t off = (size_t)(row0 + ((q) >> 1) * HALF + (2 * ((q) & 1) + mi) * 16) * D + col0 + bj * HALF; \
            if (F32IN) { rf[slot][mi][bj][0] = *(const f32x4*)(xin32 + off); rf[slot][mi][bj][1] = *(const f32x4*)(xin32 + off + 4); } else rb[slot][mi][bj] = *(const u32x4*)(xin16 + off); } } while (0)
        RESID_LOAD(0, 0);
#pragma unroll
        for (int q = 0; q < 4; ++q) { const int sl = q & 1, ai = q >> 1;
            if (q + 1 < 4) RESID_LOAD((q + 1) & 1, q + 1);
#pragma unroll
            for (int mi = 0; mi < 2; ++mi)
#pragma unroll
                for (int bj = 0; bj < 2; ++bj) { const int m = 2 * (q & 1) + mi; const size_t off = (size_t)(row0 + ai * HALF + m * 16) * D + col0 + bj * HALF;
                    f32x4 x0, x1;
                    if (F32IN) { x0 = rf[sl][mi][bj][0]; x1 = rf[sl][mi][bj][1]; }
                    else { const u32x4 xb = rb[sl][mi][bj]; x0 = (f32x4){bflo(xb.x), bfhi(xb.x), bflo(xb.y), bfhi(xb.y)}; x1 = (f32x4){bflo(xb.z), bfhi(xb.z), bflo(xb.w), bfhi(xb.w)}; }
                    const f32x4 o0 = x0 + gv[bj][0] * acc[ai][bj][m][0], o1 = x1 + gv[bj][1] * acc[ai][bj][m][1];
                    u32x4 w; w.x = cvt_pk_bf16(o0[0], o0[1]); w.y = cvt_pk_bf16(o0[2], o0[3]); w.z = cvt_pk_bf16(o1[0], o1[1]); w.w = cvt_pk_bf16(o1[2], o1[3]);
                    *(u32x4*)(xout + off) = w; }
        }
#undef RESID_LOAD
    }
};
struct EpiGateUp {
    static constexpr bool PERM = true, SUBUNITS = false;
    bf16_t* act;
    __device__ __forceinline__ void operator()(const f32x4 (&acc)[2][2][4][2], const MUnit& u, int wr, int wc, int fr, int fq) const {
        const int r0 = wr * 64 + fr, col0 = u.pn * HALF + wc * 32 + 8 * fq;
#pragma unroll
        for (int ai = 0; ai < 2; ++ai)
#pragma unroll
            for (int m = 0; m < 4; ++m) { const int r = r0 + ai * HALF + m * 16;
                if (u.pos0 + r < u.cnt) {
                    const f32x4 g0 = acc[ai][0][m][0], g1 = acc[ai][0][m][1], u0 = acc[ai][1][m][0], u1 = acc[ai][1][m][1];
                    u32x4 w; w.x = cvt_pk_bf16(silu_f(g0[0]) * u0[0], silu_f(g0[1]) * u0[1]); w.y = cvt_pk_bf16(silu_f(g0[2]) * u0[2], silu_f(g0[3]) * u0[3]);
                    w.z = cvt_pk_bf16(silu_f(g1[0]) * u1[0], silu_f(g1[1]) * u1[1]); w.w = cvt_pk_bf16(silu_f(g1[2]) * u1[2], silu_f(g1[3]) * u1[3]);
                    *(u32x4*)(act + ((size_t)(u.pm * 8 + (col0 >> 6)) * BM + r) * 64 + (col0 & 63)) = w; } }
    }
};
struct EpiDown {
    static constexpr bool PERM = true, SUBUNITS = false, WANTS_UI = true;
    bf16_t* ybuf; const int* stok; const float* sw;
    __device__ __forceinline__ void fill_table(const MUnit& u, int ti, int tid, LAS unsigned char* lds) const {
        if (tid < 256) { const int pos = u.pos0 + tid; int meta = -1; float wv = 0.f;
            if (pos < u.cnt) { const size_t si = (size_t)u.e * CAP + pos; meta = stok[si]; wv = sw[si]; }
            *(LAS u32x2*)(lds + LDS_RTAB + ti * 4096 + tid * 8) = (u32x2){(unsigned)meta, __builtin_bit_cast(unsigned, wv)}; }
    }
    __device__ __forceinline__ void fin(const f32x4 (&acc)[2][2][4][2], const MUnit& u, int ui, int wr, int wc, int fr, int fq, LAS unsigned char* lds) const {
        const int r0 = wr * 64 + fr, col0 = u.pn * BM + wc * 32 + 8 * fq;
        unsigned tb = (unsigned)(LDS_RTAB + ui * 4096 + r0 * 8); asm volatile("" : "+v"(tb));
#pragma unroll
        for (int ai = 0; ai < 2; ++ai)
#pragma unroll
            for (int m = 0; m < 4; ++m) { unsigned mx, my;
                if (ui < RTAB_MAXU) { const u32x2 mw = *(const LAS u32x2*)(lds + tb + (ai * HALF + m * 16) * 8); mx = mw.x; my = mw.y; }
                else { const int r = r0 + ai * HALF + m * 16; mx = 0xffffffffu; my = 0u;
                    if (u.pos0 + r < u.cnt) { const size_t si = (size_t)u.e * CAP + u.pos0 + r; mx = (unsigned)stok[si]; my = __builtin_bit_cast(unsigned, sw[si]); } }
                asm volatile("" : "+v"(mx), "+v"(my));
                const int meta = (int)mx; const float wv = __builtin_bit_cast(float, my);
                if (meta >= 0) {
                    bf16_t* rowp = ybuf + (size_t)meta * D + col0;
#pragma unroll
                    for (int bj = 0; bj < 2; ++bj) { const f32x4 v0 = acc[ai][bj][m][0] * wv, v1 = acc[ai][bj][m][1] * wv;
                        u32x4 w; w.x = cvt_pk_bf16(v0[0], v0[1]); w.y = cvt_pk_bf16(v0[2], v0[3]); w.z = cvt_pk_bf16(v1[0], v1[1]); w.w = cvt_pk_bf16(v1[2], v1[3]);
                        *(u32x4*)(rowp + bj * HALF) = w; } } }
    }
};
}

struct Params {
    const float *x, *c, *w_ada, *b_ada, *n1g, *n2g, *w_in, *w_ret_o, *pool_w, *pool_scale, *w_pool_o, *w_out, *w_router, *b_router, *w_eg, *w_eu, *w_ed, *final_g;
    float* out; unsigned char* ws; int ph_lo, ph_hi;
};

struct Ctx {
    LAS unsigned char* lds; int tid, lane, wave, G, bx;
};
__device__ __forceinline__ Ctx make_ctx(LAS unsigned char* lds) {
    Ctx F; int t = threadIdx.x; asm volatile("" : "+v"(t)); int bx = blockIdx.x; asm volatile("" : "+s"(bx));
    F.lds = lds; F.tid = t; F.lane = t & 63; F.wave = rfl(t >> 6); F.G = gridDim.x; F.bx = bx; return F;
}

__device__ __forceinline__ void phase_prologue(const Params& p, const Ctx& F) {
    LAS float* cond = (LAS float*)F.lds;
    LAS float* red = (LAS float*)(F.lds + 65536);
    {
#pragma unroll
        for (int h = 0; h < 2; ++h) { float cv[16];
#pragma unroll
            for (int k = 0; k < 16; ++k) cv[k] = p.c[F.tid + (h * 16 + k) * NTHR];
#pragma unroll
            for (int k = 0; k < 16; ++k) { const int i = F.tid + (h * 16 + k) * NTHR; cond[(i & (D - 1)) * NB + (i >> 10)] = silu_f(cv[k]); } }
    }
    __syncthreads();
    float* mod = (float*)(p.ws + WS_MOD);
    for (int item = F.bx; item < DEPTH * 192; item += F.G) {
        const int l = item / 192, jb = item % 192; const int hw = F.lane >> 5, cl = F.lane & 31;
        const float* w = p.w_ada + (size_t)l * D * 6144 + jb * 32 + cl + (size_t)(F.wave * 128 + hw) * 6144;
        float acc[NB];
#pragma unroll
        for (int b = 0; b < NB; ++b) acc[b] = 0.f;
        for (int i0 = 0; i0 < 64; i0 += 16) {
            float tv[16];
#pragma unroll
            for (int i = 0; i < 16; ++i) tv[i] = w[(size_t)(2 * (i0 + i)) * 6144];
            int dbase = F.wave * 128 + 2 * i0 + hw; asm volatile("" : "+v"(dbase));
#pragma unroll
            for (int i = 0; i < 16; ++i) { const int d = dbase + 2 * i;
                const LAS float* cp = cond + d * NB; const float t = tv[i];
                const f32x4 c0 = *(const LAS f32x4*)(cp), c1 = *(const LAS f32x4*)(cp + 4), c2 = *(const LAS f32x4*)(cp + 8), c3 = *(const LAS f32x4*)(cp + 12);
                acc[0] += c0[0] * t; acc[1] += c0[1] * t; acc[2] += c0[2] * t; acc[3] += c0[3] * t; acc[4] += c1[0] * t; acc[5] += c1[1] * t; acc[6] += c1[2] * t; acc[7] += c1[3] * t;
                acc[8] += c2[0] * t; acc[9] += c2[1] * t; acc[10] += c2[2] * t; acc[11] += c2[3] * t; acc[12] += c3[0] * t; acc[13] += c3[1] * t; acc[14] += c3[2] * t; acc[15] += c3[3] * t; }
        }
#pragma unroll
        for (int b = 0; b < NB; ++b) { acc[b] += __shfl_xor(acc[b], 32); if (hw == 0) red[(F.wave * NB + b) * 32 + cl] = acc[b]; }
        __syncthreads();
        { const int b = F.tid >> 5, ln = F.tid & 31; float sm = 0.f;
#pragma unroll
            for (int w8 = 0; w8 < 8; ++w8) sm += red[(w8 * NB + b) * 32 + ln];
            mod[(size_t)(l * NB + b) * 6144 + jb * 32 + ln] = sm + p.b_ada[l * 6144 + jb * 32 + ln]; }
        __syncthreads();
    }
    float* cosT = (float*)(p.ws + WS_ROPE); float* sinT = cosT + SEQ * 64;
    for (int i = F.bx * NTHR + F.tid; i < SEQ * 64; i += F.G * NTHR) { const int pos = i >> 6, fi = i & 63;
        const float freq = exp2f(-(float)fi * (13.287712379549449f / 64.0f));
        const float ang = (float)pos * freq;
        const float rev = ang * 0.15915494309189535f; const float fr = rev - floorf(rev);
        cosT[i] = __builtin_amdgcn_cosf(fr); sinT[i] = __builtin_amdgcn_sinf(fr); }
    float* dq = (float*)(p.ws + WS_DEC); float* dk = dq + 4 * SEQ;
    for (int i = F.bx * NTHR + F.tid; i < 4 * SEQ; i += F.G * NTHR) { const int h = i >> 11, pos = i & (SEQ - 1);
        const float lg = log2f(1.0f - exp2f(-5.0f - (float)h)); dq[i] = exp2f(lg * (float)pos); dk[i] = exp2f(-lg * (float)pos); }
}

__device__ __forceinline__ void transpose_item(const float* W, int N, bf16_t* WT, int Kd, int k0, int n0, int drow0, LAS float* scr, int lane, int rot = 0, int i0 = 0, int rot_half = 0, float scale = 1.0f) {
#pragma unroll 8
    for (int i = 0; i < 32; ++i) { const int kk = 2 * i + (lane >> 5); scr[kk * 33 + (lane & 31)] = W[(size_t)(k0 + kk) * N + n0 + (lane & 31)]; }
    asm volatile("s_waitcnt lgkmcnt(0)" ::: "memory");
    const int c = lane & 7;
#pragma unroll
    for (int j = 0; j < 4; ++j) { const int n = (lane >> 3) + 8 * j; const LAS float* s = scr + (8 * c) * 33 + n;
        u32x4 o; o.x = cvt_pk_bf16(s[0 * 33] * scale, s[1 * 33] * scale); o.y = cvt_pk_bf16(s[2 * 33] * scale, s[3 * 33] * scale); o.z = cvt_pk_bf16(s[4 * 33] * scale, s[5 * 33] * scale); o.w = cvt_pk_bf16(s[6 * 33] * scale, s[7 * 33] * scale);
        const int ii = i0 + n; const int drow = rot ? drow0 + 32 * (ii >> 4) + 8 * ((ii >> 2) & 3) + 4 * rot_half + (ii & 3) : drow0 + n;
        *(u32x4*)(WT + (size_t)drow * Kd + k0 + 8 * c) = o; }
    asm volatile("s_waitcnt lgkmcnt(0)" ::: "memory");
}
__device__ __forceinline__ void transpose_item64(const float* W, int N, bf16_t* WT, int Kd, int k0, int n0, int drow0, LAS float* scr, int lane) {
    const float* src = W + (size_t)k0 * N + n0 + lane;
#pragma unroll 16
    for (int kk = 0; kk < 64; ++kk) scr[kk * 65 + lane] = src[(size_t)kk * N];
    asm volatile("s_waitcnt lgkmcnt(0)" ::: "memory");
    const int c = lane & 7;
#pragma unroll
    for (int j = 0; j < 8; ++j) { const int n = (lane >> 3) + 8 * j; const LAS float* s = scr + (8 * c) * 65 + n;
        u32x4 o; o.x = cvt_pk_bf16(s[0 * 65], s[1 * 65]); o.y = cvt_pk_bf16(s[2 * 65], s[3 * 65]); o.z = cvt_pk_bf16(s[4 * 65], s[5 * 65]); o.w = cvt_pk_bf16(s[6 * 65], s[7 * 65]);
        *(u32x4*)(WT + (size_t)(drow0 + n) * Kd + k0 + 8 * c) = o; }
    asm volatile("s_waitcnt lgkmcnt(0)" ::: "memory");
}
__device__ __forceinline__ void convert_layer_weights(const Params& p, const Ctx& F, int l) {
    LAS float* scr = (LAS float*)(F.lds + F.wave * 17408);
    const int gw = F.bx * NWAVES + F.wave, NGW = F.G * NWAVES;
    constexpr int I_QK = 16 * 32, I_IN = 16 * 72, I_RO = 16 * 16, I_OUT = 16 * 16, I_G = 16 * 16 * 8, I_U = I_G, I_DN = 16 * 8 * 16, I_PE = 4 * 16 * 32;
    constexpr int NITEMS = I_QK + I_IN + I_RO + I_OUT + I_G + I_U + I_DN + I_PE;
    unsigned char* ws = p.ws;
    for (int it = gw; it < NITEMS; it += NGW) {
        int r = it;
        if (r < I_QK) { const int kb = r / 32, nb = r % 32; const int n0 = nb * 32;
            transpose_item(p.w_in + (size_t)l * D * INW, INW, (bf16_t*)(ws + WT_IN), D, kb * 64, n0, n0 & ~127, scr, F.lane, 1, n0 & 63, (n0 >> 6) & 1, n0 >= 512 ? 0.08838834764831845f : 1.0f);
            continue; } r -= I_QK;
        if (r < I_IN) { const int kb = r / 72, nb = r % 72; const int n0 = 1024 + nb * 64;
            transpose_item64(p.w_in + (size_t)l * D * INW, INW, (bf16_t*)(ws + WT_IN), D, kb * 64, n0, n0, scr, F.lane); continue; } r -= I_IN;
        if (r < I_RO) { const int kb = r / 16, nb = r % 16; transpose_item64(p.w_ret_o + (size_t)l * D * D, D, (bf16_t*)(ws + WT_RO), D, kb * 64, nb * 64, nb * 64, scr, F.lane); continue; } r -= I_RO;
        if (r < I_OUT) { const int kb = r / 16, nb = r % 16; transpose_item64(p.w_out + (size_t)l * D * D, D, (bf16_t*)(ws + WT_OUT), D, kb * 64, nb * 64, nb * 64, scr, F.lane); continue; } r -= I_OUT;
        if (r < I_G + I_U) { const int half = r / I_G; const int q = r % I_G; const int e = q / 128, kb = (q % 128) / 8, nb = q % 8; const int n0 = nb * 64;
            const float* W = (half ? p.w_eu : p.w_eg) + ((size_t)l * NE + e) * D * DE;
            transpose_item64(W, DE, (bf16_t*)(ws + WT_GU) + (size_t)e * 1024 * D, D, kb * 64, n0, (n0 >> 7) * 256 + half * 128 + (n0 & 127), scr, F.lane); continue; } r -= I_G + I_U;
        if (r < I_DN) { const int e = r / 128, kb = (r % 128) / 16, nb = r % 16;
            transpose_item64(p.w_ed + ((size_t)l * NE + e) * DE * D, D, (bf16_t*)(ws + WT_DN) + (size_t)e * D * DE, DE, kb * 64, nb * 64, nb * 64, scr, F.lane); continue; } r -= I_DN;
        {
            const int g = r / 512, nb = (r % 512) / 32, cb = r % 32; const int n = nb * 64 + F.lane, c0 = cb * 4;
            const float* pw = p.pool_w + ((size_t)(l * 4 + g) * 128 + c0) * 128; const float* ps = p.pool_scale + l * 512 + g * 128;
            { float pa[8], pb[8];
#pragma unroll
              for (int k = 0; k < 8; ++k) { pa[k] = pw[F.lane + 64 * k]; pb[k] = ps[(F.lane + 64 * k) & 127]; }
#pragma unroll
              for (int k = 0; k < 8; ++k) scr[F.lane + 64 * k] = pa[k] * pb[k]; }
            asm volatile("s_waitcnt lgkmcnt(0)" ::: "memory");
            const float* wo = p.w_pool_o + ((size_t)l * 512 + g * 128) * D + n;
            float acc[4];
#pragma unroll
            for (int c = 0; c < 4; ++c) acc[c] = 0.f;
            for (int d0 = 0; d0 < 128; d0 += 32) {
                float tv[32];
#pragma unroll
                for (int i = 0; i < 32; ++i) tv[i] = wo[(size_t)(d0 + i) * D];
#pragma unroll
                for (int i = 0; i < 32; ++i)
#pragma unroll
                    for (int c = 0; c < 4; ++c) acc[c] += scr[c * 128 + d0 + i] * tv[i]; }
            u32x2 o0; o0.x = cvt_pk_bf16(acc[0], acc[1]); o0.y = cvt_pk_bf16(acc[2], acc[3]);
            *(u32x2*)((bf16_t*)(ws + WT_PE) + (size_t)n * 512 + g * 128 + c0) = o0;
            asm volatile("s_waitcnt lgkmcnt(0)" ::: "memory");
        }
    }
}

struct MoeSplit { int U, ufull, R; };
__device__ __forceinline__ MoeSplit moe_split(const LAS int* lc, int G) {
    int mt = 0;
#pragma unroll
    for (int e = 0; e < NE; ++e) mt += (lc[e] + 255) >> 8;
    MoeSplit r; r.U = mt * 4; const int rounds = (r.U + G - 1) / G; const int rem = r.U - (rounds - 1) * G;
    const bool split = rounds >= 2 && rem * 2 <= G;
    r.ufull = split ? (rounds - 1) * G : r.U; r.R = split ? rem : 0; return r;
}

__device__ __forceinline__ void phase_norm1(const Params& p, const Ctx& F, int l, int nrep) {
    for (int rep = 0; rep < NREP(0); ++rep) convert_layer_weights(p, F, l);
    const float* mod = (const float*)(p.ws + WS_MOD);
    const bf16_t* ybuf = (const bf16_t*)(p.ws + WS_YBUF);
    bf16_t* H = (bf16_t*)(p.ws + WS_H);
    bf16_t* XB = (bf16_t*)(p.ws + WS_XB);
    const int gw = F.bx * NWAVES + F.wave, NGW = F.G * NWAVES;
    for (int rep = 0; rep < nrep; ++rep)
    for (int blk = gw; blk < T / 16; blk += NGW) {
        const bool dummy = rep + 1 < nrep;
        const int row0 = blk * 16, b = row0 / SEQ;
        const float* m1 = mod + (size_t)(l * NB + b) * 6144;
        f32x4 av[4], cv[4], g2v[4];
#pragma unroll
        for (int i = 0; i < 4; ++i) { const int d = i * 256 + F.lane * 4;
            const f32x4 g = *(const f32x4*)(p.n1g + l * D + d), sc = *(const f32x4*)(m1 + 1024 + d);
            av[i] = g * (sc + 1.0f); cv[i] = *(const f32x4*)(m1 + d);
            g2v[i] = (f32x4){0.f, 0.f, 0.f, 0.f};
            if (l > 0) g2v[i] = *(const f32x4*)(mod + (size_t)((l - 1) * NB + b) * 6144 + 5120 + d); }
        f32x4 nf[4]; u32x2 nxb[4], ny0[4], ny1[4];
#pragma unroll
        for (int i = 0; i < 4; ++i) { const int d = i * 256 + F.lane * 4; const size_t row = (size_t)row0;
            if (l == 0) nf[i] = *(const f32x4*)(p.x + row * D + d);
            else { nxb[i] = *(const u32x2*)(XB + row * D + d); ny0[i] = *(const u32x2*)(ybuf + (2 * row) * D + d); ny1[i] = *(const u32x2*)(ybuf + (2 * row + 1) * D + d); } }
        for (int r = 0; r < 16; ++r) {
            const size_t row = (size_t)(row0 + r);
            f32x4 v[4]; u32x2 y0[4], y1[4]; float ss = 0.f;
#pragma unroll
            for (int i = 0; i < 4; ++i) { if (l == 0) v[i] = nf[i]; else { v[i] = (f32x4){bflo(nxb[i].x), bfhi(nxb[i].x), bflo(nxb[i].y), bfhi(nxb[i].y)}; y0[i] = ny0[i]; y1[i] = ny1[i]; } }
            if (r + 1 < 16) {
#pragma unroll
                for (int i = 0; i < 4; ++i) { const int d = i * 256 + F.lane * 4; const size_t rn = row + 1;
                    if (l == 0) nf[i] = *(const f32x4*)(p.x + rn * D + d);
                    else { nxb[i] = *(const u32x2*)(XB + rn * D + d); ny0[i] = *(const u32x2*)(ybuf + (2 * rn) * D + d); ny1[i] = *(const u32x2*)(ybuf + (2 * rn + 1) * D + d); } } }
#pragma unroll
            for (int i = 0; i < 4; ++i) { const int d = i * 256 + F.lane * 4;
                if (l != 0) {
                    f32x4 ys; ys[0] = bflo(y0[i].x) + bflo(y1[i].x); ys[1] = bfhi(y0[i].x) + bfhi(y1[i].x); ys[2] = bflo(y0[i].y) + bflo(y1[i].y); ys[3] = bfhi(y0[i].y) + bfhi(y1[i].y);
                    v[i] = v[i] + g2v[i] * ys;
                    if (!dummy) { u32x2 xw; xw.x = cvt_pk_bf16(v[i][0], v[i][1]); xw.y = cvt_pk_bf16(v[i][2], v[i][3]); *(u32x2*)(XB + row * D + d) = xw; } }
                ss += (v[i][0] * v[i][0] + v[i][1] * v[i][1]) + (v[i][2] * v[i][2] + v[i][3] * v[i][3]); }
            const float rstd = rsqrtf(wave_sum(ss) * (1.0f / D) + EPS);
#pragma unroll
            for (int i = 0; i < 4; ++i) { const int d = i * 256 + F.lane * 4; const f32x4 h = v[i] * rstd * av[i] + cv[i];
                u32x2 w; w.x = cvt_pk_bf16(h[0], h[1]); w.y = cvt_pk_bf16(h[2], h[3]);
                *(u32x2*)(H + row * D + d) = w; }
        }
    }
}

constexpr int RSK = 272, RSV = 144;
typedef short s16x4 __attribute__((ext_vector_type(4)));
__device__ __forceinline__ bf16x8 tr16x2(const LAS unsigned char* a0, const LAS unsigned char* a1) {
    const s16x4 lo = __builtin_amdgcn_ds_read_tr16_b64_v4i16((LAS s16x4*)a0), hi = __builtin_amdgcn_ds_read_tr16_b64_v4i16((LAS s16x4*)a1);
    return (bf16x8){lo[0], lo[1], lo[2], lo[3], hi[0], hi[1], hi[2], hi[3]};
}
__device__ __forceinline__ void phase_ret2(const Params& p, const Ctx& F, int vcu) {
    LAS unsigned char* Kim = F.lds;
    LAS unsigned char* Vim = F.lds + 34816;
    LAS unsigned char* StT = F.lds + 71680;
    LAS unsigned char* Pim = F.lds + 106496 + F.wave * (16 * RSK);
    bf16_t* P = (bf16_t*)(p.ws + WS_U);
    float* ssq = (float*)(p.ws + WS_SSQ);
    const int w = F.wave, fr = F.lane & 15, fg = F.lane >> 4, tq = fr >> 2, tp = F.lane & 3;
    unsigned oRow = (unsigned)(fr * RSK + 16 * fg), oPw = (unsigned)(fr * RSK + 8 * fg), oSw = (unsigned)(fr * RSK + 32 * w + 8 * fg);
    unsigned oTk = (unsigned)((8 * fg + tq) * RSK + 32 * w + 8 * tp), oTv = (unsigned)((8 * fg + tq) * RSV + 8 * tp), oTp = (unsigned)((4 * fg + tq) * RSV + 8 * tp);
    unsigned oKs = (unsigned)((F.tid >> 4) * RSK + (F.tid & 15) * 16), oVs = (unsigned)((F.tid >> 3) * RSV + (F.tid & 7) * 16);
    asm volatile("" : "+v"(oRow), "+v"(oPw), "+v"(oSw), "+v"(oTk), "+v"(oTv), "+v"(oKs), "+v"(oVs), "+v"(oTp));
    for (int rep2 = 0; rep2 < NREP(2); ++rep2) { const bool dummy = rep2 + 1 < NREP(2);
    for (int u = vcu; u < NB * 16; u += F.G) {
        const int s = u & 3, h = (u >> 2) & 3, b = u >> 4;
        __syncthreads();
        { unsigned z0 = 0u; asm volatile("" : "+v"(z0));
          for (int i = F.tid; i < 64 * RSK / 16; i += NTHR) *(LAS u32x4*)(StT + i * 16) = (u32x4){z0, z0, z0, z0}; }
        f32x4 st[4];
#pragma unroll
        for (int i = 0; i < 4; ++i) st[i] = (f32x4){0.f, 0.f, 0.f, 0.f};
        const size_t rowb = (size_t)b * SEQ;
        const bf16_t* kbase = (const bf16_t*)(p.ws + WS_KB) + (size_t)((b * 4 + h) * SEQ) * 128; const bf16_t* qbase = (const bf16_t*)(p.ws + WS_QB) + (size_t)((b * 4 + h) * SEQ) * 128;
        bf16_t* vbase = (bf16_t*)(p.ws + WS_VB) + (size_t)(((b * 4 + h) * 4 + s) * SEQ) * 64; const bf16_t* gbase = (const bf16_t*)(p.ws + WS_GB) + (size_t)(((b * 4 + h) * 4 + s) * SEQ) * 64;
        u32x4 kr[4], vr[2], qr[4];
#define RET_LOAD_CHUNK(nn) do { \
            _Pragma("unroll") for (int i_ = 0; i_ < 4; ++i_) { const int id_ = F.tid + NTHR * i_; kr[i_] = *(const u32x4*)(kbase + (size_t)((nn) * 128 + (id_ >> 4)) * 128 + (id_ & 15) * 8); } \
            _Pragma("unroll") for (int i_ = 0; i_ < 2; ++i_) { const int id_ = F.tid + NTHR * i_; vr[i_] = *(const u32x4*)(vbase + (size_t)((nn) * 128 + (id_ >> 3)) * 64 + (id_ & 7) * 8); } \
            _Pragma("unroll") for (int k_ = 0; k_ < 4; ++k_) qr[k_] = *(const u32x4*)(qbase + (size_t)((nn) * 128 + 16 * w + fr) * 128 + 32 * k_ + 8 * fg); } while (0)
        RET_LOAD_CHUNK(0);
        for (int n = 0; n < 16; ++n) {
#pragma unroll
            for (int i = 0; i < 4; ++i) *(LAS u32x4*)(Kim + oKs + i * 32 * RSK) = kr[i];
#pragma unroll
            for (int i = 0; i < 2; ++i) *(LAS u32x4*)(Vim + oVs + i * 64 * RSV) = vr[i];
            bf16x8 qf[4];
#pragma unroll
            for (int ks = 0; ks < 4; ++ks) qf[ks] = __builtin_bit_cast(bf16x8, qr[ks]);
            if (n + 1 < 16) RET_LOAD_CHUNK(n + 1);
            const size_t row = rowb + n * 128 + 16 * w + fr;
            u32x2 gr[4];
#pragma unroll
            for (int u4 = 0; u4 < 4; ++u4) gr[u4] = *(const u32x2*)(gbase + (size_t)(n * 128 + 16 * w + fr) * 64 + 16 * u4 + 4 * fg);
            __syncthreads();
            if (NREP(18) > 1) __syncthreads();
            const LAS unsigned char* Scur = StT + (n & 1) * (64 * RSK); LAS unsigned char* Snxt = StT + ((n + 1) & 1) * (64 * RSK);
            f32x4 yi[4];
#pragma unroll
            for (int i = 0; i < 4; ++i) yi[i] = (f32x4){0.f, 0.f, 0.f, 0.f};
#pragma unroll
            for (int kp = 0; kp < 4; ++kp) {
                if (2 * kp <= w) {
                    f32x4 a0 = (f32x4){0.f, 0.f, 0.f, 0.f}, a1 = (f32x4){0.f, 0.f, 0.f, 0.f};
#pragma unroll
                    for (int ks = 0; ks < 4; ++ks) { const bf16x8 kf = *(const LAS bf16x8*)(Kim + oRow + 32 * kp * RSK + 64 * ks); a0 = __builtin_amdgcn_mfma_f32_16x16x32_bf16(kf, qf[ks], a0, 0, 0, 0); }
                    if (2 * kp + 1 <= w) {
#pragma unroll
                        for (int ks = 0; ks < 4; ++ks) { const bf16x8 kf = *(const LAS bf16x8*)(Kim + oRow + (32 * kp + 16) * RSK + 64 * ks); a1 = __builtin_amdgcn_mfma_f32_16x16x32_bf16(kf, qf[ks], a1, 0, 0, 0); }
                    }
                    if (2 * kp == w) {
#pragma unroll
                        for (int r = 0; r < 4; ++r) a0[r] = (fr >= 4 * fg + r) ? a0[r] : 0.f; }
                    if (2 * kp + 1 == w) {
#pragma unroll
                        for (int r = 0; r < 4; ++r) a1[r] = (fr >= 4 * fg + r) ? a1[r] : 0.f; }
                    const bf16x8 pf = __builtin_bit_cast(bf16x8, (u32x4){cvt_pk_bf16(a0[0], a0[1]), cvt_pk_bf16(a0[2], a0[3]), cvt_pk_bf16(a1[0], a1[1]), cvt_pk_bf16(a1[2], a1[3])});
#pragma unroll
                    for (int u4 = 0; u4 < 4; ++u4) { const LAS unsigned char* va = Vim + oTp + 32 * kp * RSV + 32 * u4;
                        const bf16x8 vf = tr16x2(va, va + 16 * RSV); yi[u4] = __builtin_amdgcn_mfma_f32_16x16x32_bf16(vf, pf, yi[u4], 0, 0, 0); }
                }
            }
#pragma unroll
            for (int ks = 0; ks < 4; ++ks)
#pragma unroll
                for (int u4 = 0; u4 < 4; ++u4) { const bf16x8 sf = *(const LAS bf16x8*)(Scur + oRow + 16 * u4 * RSK + 64 * ks); yi[u4] = __builtin_amdgcn_mfma_f32_16x16x32_bf16(sf, qf[ks], yi[u4], 0, 0, 0); }
            if (NREP(16) > 1) {
                f32x4 yd[4];
#pragma unroll
                for (int i = 0; i < 4; ++i) yd[i] = (f32x4){0.f, 0.f, 0.f, 0.f};
#pragma unroll
                for (int kp = 0; kp < 4; ++kp) {
                    if (2 * kp <= w) {
                        f32x4 a0 = (f32x4){0.f, 0.f, 0.f, 0.f}, a1 = (f32x4){0.f, 0.f, 0.f, 0.f};
#pragma unroll
                        for (int ks = 0; ks < 4; ++ks) { const bf16x8 kf = *(const volatile LAS bf16x8*)(Kim + oRow + 32 * kp * RSK + 64 * ks); a0 = __builtin_amdgcn_mfma_f32_16x16x32_bf16(kf, qf[ks], a0, 0, 0, 0); }
                        if (2 * kp + 1 <= w) {
#pragma unroll
                            for (int ks = 0; ks < 4; ++ks) { const bf16x8 kf = *(const volatile LAS bf16x8*)(Kim + oRow + (32 * kp + 16) * RSK + 64 * ks); a1 = __builtin_amdgcn_mfma_f32_16x16x32_bf16(kf, qf[ks], a1, 0, 0, 0); }
                        }
                        const bf16x8 pf = __builtin_bit_cast(bf16x8, (u32x4){cvt_pk_bf16(a0[0], a0[1]), cvt_pk_bf16(a0[2], a0[3]), cvt_pk_bf16(a1[0], a1[1]), cvt_pk_bf16(a1[2], a1[3])});
#pragma unroll
                        for (int u4 = 0; u4 < 4; ++u4) { const LAS unsigned char* va = Vim + oTp + 32 * kp * RSV + 32 * u4;
                            const bf16x8 vf = tr16x2(va, va + 16 * RSV); yd[u4] = __builtin_amdgcn_mfma_f32_16x16x32_bf16(vf, pf, yd[u4], 0, 0, 0); }
                    }
                }
#pragma unroll
                for (int ks = 0; ks < 4; ++ks)
#pragma unroll
                    for (int u4 = 0; u4 < 4; ++u4) { const bf16x8 sf = *(const volatile LAS bf16x8*)(Scur + oRow + 16 * u4 * RSK + 64 * ks); yd[u4] = __builtin_amdgcn_mfma_f32_16x16x32_bf16(sf, qf[ks], yd[u4], 0, 0, 0); }
                asm volatile("" :: "v"(yd[0]), "v"(yd[1]), "v"(yd[2]), "v"(yd[3]));
            }
            {
                float ss = 0.f;
#pragma unroll
                for (int u4 = 0; u4 < 4; ++u4) { const f32x4 y = yi[u4]; ss += (y[0] * y[0] + y[1] * y[1]) + (y[2] * y[2] + y[3] * y[3]);
                    u32x2 yw; yw.x = cvt_pk_bf16(silu_f(bflo(gr[u4].x)) * y[0], silu_f(bfhi(gr[u4].x)) * y[1]); yw.y = cvt_pk_bf16(silu_f(bflo(gr[u4].y)) * y[2], silu_f(bfhi(gr[u4].y)) * y[3]);
                    if (dummy) *(u32x2*)((bf16_t*)(p.ws + WS_SCR) + row * D + h * 256 + s * 64 + 16 * u4 + 4 * fg) = yw;
                    else *(u32x2*)(vbase + (size_t)(n * 128 + 16 * w + fr) * 64 + 16 * u4 + 4 * fg) = yw; }
                ss += __shfl_xor(ss, 16); ss += __shfl_xor(ss, 32);
                if (fg == 0) ssq[row * 16 + h * 4 + s] = ss;
            }
#pragma unroll
            for (int ks = 0; ks < 4; ++ks) {
                const LAS unsigned char* ka = Kim + oTk + 32 * ks * RSK;
                const bf16x8 kz = tr16x2(ka, ka + 4 * RSK);
#pragma unroll
                for (int u4 = 0; u4 < 4; ++u4) { const LAS unsigned char* va = Vim + oTv + 32 * ks * RSV + 32 * u4;
                    const bf16x8 vz = tr16x2(va, va + 4 * RSV); st[u4] = __builtin_amdgcn_mfma_f32_16x16x32_bf16(kz, vz, st[u4], 0, 0, 0); }
            }
            if (NREP(17) > 1) {
                f32x4 sd[4];
#pragma unroll
                for (int i = 0; i < 4; ++i) sd[i] = (f32x4){0.f, 0.f, 0.f, 0.f};
#pragma unroll
                for (int ks = 0; ks < 4; ++ks) {
                    const LAS unsigned char* ka = Kim + oTk + 32 * ks * RSK;
                    const bf16x8 kz = tr16x2(ka, ka + 4 * RSK);
#pragma unroll
                    for (int u4 = 0; u4 < 4; ++u4) { const LAS unsigned char* va = Vim + oTv + 32 * ks * RSV + 32 * u4;
                        const bf16x8 vz = tr16x2(va, va + 4 * RSV); sd[u4] = __builtin_amdgcn_mfma_f32_16x16x32_bf16(kz, vz, sd[u4], 0, 0, 0); }
                }
                asm volatile("" :: "v"(sd[0]), "v"(sd[1]), "v"(sd[2]), "v"(sd[3]));
            }
#pragma unroll
            for (int u4 = 0; u4 < 4; ++u4) { u32x2 sw2; sw2.x = cvt_pk_bf16(st[u4][0], st[u4][1]); sw2.y = cvt_pk_bf16(st[u4][2], st[u4][3]);
                *(LAS u32x2*)(Snxt + oSw + 16 * u4 * RSK) = sw2; }
            __syncthreads();
        }
#undef RET_LOAD_CHUNK
    }
    }
    for (int rep3 = 0; rep3 < NREP(14); ++rep3) {
    bf16_t* MX = (bf16_t*)(p.ws + WS_H);
    const int gw = F.bx * NWAVES + F.wave, NGW = F.G * NWAVES;
    const int c = F.lane * 8, grp = F.lane >> 4, win = 2 << grp;
    for (int blk = gw; blk < T / 8; blk += NGW) {
        const int row0 = blk * 8; const int pos0 = row0 & (SEQ - 1);
        u32x4 R[23];
#pragma unroll
        for (int i = 0; i < 23; ++i) R[i] = *(const u32x4*)(P + ((long)(row0 - 15 + i) * 512) + c);
        if (pos0 < 15) {
#pragma unroll
            for (int i = 0; i < 15; ++i) if (pos0 - 15 + i < 0) R[i] = (u32x4){0u, 0u, 0u, 0u}; }
        float acc[8];
#pragma unroll
        for (int k = 0; k < 8; ++k) acc[k] = 0.f;
#pragma clang loop unroll(full)
        for (int j = 0; j < 16; ++j) { u32x4 uv = R[15 - j]; if (!(j < win)) uv = (u32x4){0u, 0u, 0u, 0u};
            acc[0] += bflo(uv.x); acc[1] += bfhi(uv.x); acc[2] += bflo(uv.y); acc[3] += bfhi(uv.y); acc[4] += bflo(uv.z); acc[5] += bfhi(uv.z); acc[6] += bflo(uv.w); acc[7] += bfhi(uv.w); }
#pragma clang loop unroll(full)
        for (int r = 0; r < 8; ++r) {
            const int pos = pos0 + r; const int cnt = (pos + 1) < win ? (pos + 1) : win;
            if (r > 0) { const u32x4 nv = R[15 + r]; const u32x4 o2 = R[13 + r], o4 = R[11 + r], o8 = R[7 + r], o16 = R[r - 1 < 0 ? 0 : r - 1];
                u32x4 ov = grp == 0 ? o2 : (grp == 1 ? o4 : (grp == 2 ? o8 : o16));
                acc[0] += bflo(nv.x) - bflo(ov.x); acc[1] += bfhi(nv.x) - bfhi(ov.x); acc[2] += bflo(nv.y) - bflo(ov.y); acc[3] += bfhi(nv.y) - bfhi(ov.y);
                acc[4] += bflo(nv.z) - bflo(ov.z); acc[5] += bfhi(nv.z) - bfhi(ov.z); acc[6] += bflo(nv.w) - bflo(ov.w); acc[7] += bfhi(nv.w) - bfhi(ov.w); }
            const u32x4 cu = R[15 + r]; const float inv = 1.0f / (float)cnt;
            u32x4 wv; wv.x = cvt_pk_bf16(acc[0] * inv - bflo(cu.x), acc[1] * inv - bfhi(cu.x)); wv.y = cvt_pk_bf16(acc[2] * inv - bflo(cu.y), acc[3] * inv - bfhi(cu.y));
            wv.z = cvt_pk_bf16(acc[4] * inv - bflo(cu.z), acc[5] * inv - bfhi(cu.z)); wv.w = cvt_pk_bf16(acc[6] * inv - bflo(cu.w), acc[7] * inv - bfhi(cu.w));
            *(u32x4*)(MX + (size_t)(row0 + r) * 512 + c) = wv;
        }
    }
    }
}

__device__ __forceinline__ void phase_ret3(const Params& p, const Ctx& F, int vcu) {
    LAS unsigned char* Kb = F.lds;
    LAS unsigned char* Vb = F.lds + 65536;
    LAS unsigned char* StT = F.lds + 98304;
    bf16_t* P = (bf16_t*)(p.ws + WS_U);
    float* ssq = (float*)(p.ws + WS_SSQ);
    const int w = F.wave, lane = F.lane, fr = lane & 15, fg = lane >> 4, tq = fr >> 2, tp = lane & 3;
    unsigned oK0 = (unsigned)(fr * 256 + (((0 + fg) ^ fr) << 4)), oK1 = (unsigned)(fr * 256 + (((4 + fg) ^ fr) << 4)), oK2 = (unsigned)(fr * 256 + (((8 + fg) ^ fr) << 4)), oK3 = (unsigned)(fr * 256 + (((12 + fg) ^ fr) << 4));
    unsigned oKt = (unsigned)((4 * fg + tq) * 256 + (((2 * w + (tp >> 1)) ^ (4 * fg + tq)) << 4) + 8 * (tp & 1));
    unsigned oV0 = (unsigned)((4 * fg + tq) * 128 + (((0 + (tp >> 1)) ^ (4 * (fg & 1) + tq)) << 4) + 8 * (tp & 1)), oV1 = (unsigned)((4 * fg + tq) * 128 + (((2 + (tp >> 1)) ^ (4 * (fg & 1) + tq)) << 4) + 8 * (tp & 1));
    unsigned oV2 = (unsigned)((4 * fg + tq) * 128 + (((4 + (tp >> 1)) ^ (4 * (fg & 1) + tq)) << 4) + 8 * (tp & 1)), oV3 = (unsigned)((4 * fg + tq) * 128 + (((6 + (tp >> 1)) ^ (4 * (fg & 1) + tq)) << 4) + 8 * (tp & 1));
    unsigned oRow = (unsigned)(fr * RSK + 16 * fg), oSw = (unsigned)(fr * RSK + 32 * w + 8 * fg);
    asm volatile("" : "+v"(oK0), "+v"(oK1), "+v"(oK2), "+v"(oK3), "+v"(oKt), "+v"(oV0), "+v"(oV1), "+v"(oV2), "+v"(oV3), "+v"(oRow), "+v"(oSw));
    const int krow = lane >> 4, kch = lane & 15, vrow = lane >> 3, vch = lane & 7;
    for (int rep2 = 0; rep2 < NREP(2); ++rep2) { const bool dummy = rep2 + 1 < NREP(2);
    for (int u = vcu; u < NB * 16; u += F.G) {
        const int s = u & 3, h = (u >> 2) & 3, b = u >> 4;
        __syncthreads();
        { unsigned z0 = 0u; asm volatile("" : "+v"(z0));
          for (int i = F.tid; i < 64 * RSK / 16; i += NTHR) *(LAS u32x4*)(StT + i * 16) = (u32x4){z0, z0, z0, z0}; }
        f32x4 st[4];
#pragma unroll
        for (int i = 0; i < 4; ++i) st[i] = (f32x4){0.f, 0.f, 0.f, 0.f};
        const size_t rowb = (size_t)b * SEQ;
        const bf16_t* kbase = (const bf16_t*)(p.ws + WS_KB) + (size_t)((b * 4 + h) * SEQ) * 128; const bf16_t* qbase = (const bf16_t*)(p.ws + WS_QB) + (size_t)((b * 4 + h) * SEQ) * 128;
        bf16_t* vbase = (bf16_t*)(p.ws + WS_VB) + (size_t)(((b * 4 + h) * 4 + s) * SEQ) * 64; const bf16_t* gbase = (const bf16_t*)(p.ws + WS_GB) + (size_t)(((b * 4 + h) * 4 + s) * SEQ) * 64;
        u32x4 qr[4]; u32x2 grn[4];
#define RET_ISSUE_K(nn) do { \
            _Pragma("unroll") for (int i_ = 0; i_ < 4; ++i_) { const int r_ = 16 * w + 4 * i_ + krow; \
                __builtin_amdgcn_global_load_lds((const unsigned*)(kbase + (size_t)((nn) * 128 + r_) * 128 + ((kch ^ (r_ & 15)) << 3)), (LAS unsigned*)(Kb + ((nn) & 1) * 32768 + (16 * w + 4 * i_) * 256), 16, 0, 0); } } while (0)
#define RET_ISSUE_V(nn) do { \
            _Pragma("unroll") for (int i_ = 0; i_ < 2; ++i_) { const int r_ = 16 * w + 8 * i_ + vrow; \
                __builtin_amdgcn_global_load_lds((const unsigned*)(vbase + (size_t)((nn) * 128 + r_) * 64 + ((vch ^ (r_ & 7)) << 3)), (LAS unsigned*)(Vb + ((nn) & 1) * 16384 + (16 * w + 8 * i_) * 128), 16, 0, 0); } } while (0)
#define RET_ISSUE_Q(nn) do { \
            _Pragma("unroll") for (int k_ = 0; k_ < 4; ++k_) qr[k_] = *(const u32x4*)(qbase + (size_t)((nn) * 128 + 16 * w + fr) * 128 + 32 * k_ + 8 * fg); } while (0)
#define RET_ISSUE_G(nn) do { \
            _Pragma("unroll") for (int u_ = 0; u_ < 4; ++u_) grn[u_] = *(const u32x2*)(gbase + (size_t)((nn) * 128 + 16 * w + fr) * 64 + 16 * u_ + 4 * fg); } while (0)
#define RET_PIN() do { asm volatile("" ::: "memory"); __builtin_amdgcn_sched_barrier(0); } while (0)
#define RET_ISSUE(nn) do { \
            _Pragma("unroll") for (int i_ = 0; i_ < 4; ++i_) { const int r_ = 16 * w + 4 * i_ + krow; \
                __builtin_amdgcn_global_load_lds((const unsigned*)(kbase + (size_t)((nn) * 128 + r_) * 128 + ((kch ^ (r_ & 15)) << 3)), (LAS unsigned*)(Kb + ((nn) & 1) * 32768 + (16 * w + 4 * i_) * 256), 16, 0, 0); } \
            _Pragma("unroll") for (int i_ = 0; i_ < 2; ++i_) { const int r_ = 16 * w + 8 * i_ + vrow; \
                __builtin_amdgcn_global_load_lds((const unsigned*)(vbase + (size_t)((nn) * 128 + r_) * 64 + ((vch ^ (r_ & 7)) << 3)), (LAS unsigned*)(Vb + ((nn) & 1) * 16384 + (16 * w + 8 * i_) * 128), 16, 0, 0); } \
            _Pragma("unroll") for (int k_ = 0; k_ < 4; ++k_) qr[k_] = *(const u32x4*)(qbase + (size_t)((nn) * 128 + 16 * w + fr) * 128 + 32 * k_ + 8 * fg); \
            _Pragma("unroll") for (int u_ = 0; u_ < 4; ++u_) grn[u_] = *(const u32x2*)(gbase + (size_t)((nn) * 128 + 16 * w + fr) * 64 + 16 * u_ + 4 * fg); } while (0)
        RET_ISSUE(0);
        bf16x8 qf[4]; u32x2 gr[4];
#pragma unroll
        for (int ks = 0; ks < 4; ++ks) qf[ks] = __builtin_bit_cast(bf16x8, qr[ks]);
#pragma unroll
        for (int u4 = 0; u4 < 4; ++u4) gr[u4] = grn[u4];
        asm volatile("s_waitcnt vmcnt(0) lgkmcnt(0)" ::: "memory");
        for (int n = 0; n < 16; ++n) {
            __builtin_amdgcn_s_barrier();
            asm volatile("" ::: "memory");
            if (n + 1 < 16) RET_ISSUE_K(n + 1);
            RET_PIN();
            const LAS unsigned char* Kim = Kb + (n & 1) * 32768; const LAS unsigned char* Vim = Vb + (n & 1) * 16384;
            const LAS unsigned char* Scur = StT + (n & 1) * (64 * RSK); LAS unsigned char* Snxt = StT + ((n + 1) & 1) * (64 * RSK);
            const size_t row = rowb + n * 128 + 16 * w + fr;
            f32x4 yi[4];
#pragma unroll
            for (int i = 0; i < 4; ++i) yi[i] = (f32x4){0.f, 0.f, 0.f, 0.f};
#pragma unroll
            for (int kp = 0; kp < 4; ++kp) {
                if (kp == 2) { RET_PIN(); if (n + 1 < 16) RET_ISSUE_V(n + 1); RET_PIN(); }
                f32x4 a0 = (f32x4){0.f, 0.f, 0.f, 0.f}, a1 = (f32x4){0.f, 0.f, 0.f, 0.f};
                { const bf16x8 k0 = *(const LAS bf16x8*)(Kim + oK0 + 32 * kp * 256), k1 = *(const LAS bf16x8*)(Kim + oK1 + 32 * kp * 256), k2 = *(const LAS bf16x8*)(Kim + oK2 + 32 * kp * 256), k3 = *(const LAS bf16x8*)(Kim + oK3 + 32 * kp * 256);
                  a0 = __builtin_amdgcn_mfma_f32_16x16x32_bf16(k0, qf[0], a0, 0, 0, 0); a0 = __builtin_amdgcn_mfma_f32_16x16x32_bf16(k1, qf[1], a0, 0, 0, 0);
                  a0 = __builtin_amdgcn_mfma_f32_16x16x32_bf16(k2, qf[2], a0, 0, 0, 0); a0 = __builtin_amdgcn_mfma_f32_16x16x32_bf16(k3, qf[3], a0, 0, 0, 0); }
                { const bf16x8 k0 = *(const LAS bf16x8*)(Kim + oK0 + (32 * kp + 16) * 256), k1 = *(const LAS bf16x8*)(Kim + oK1 + (32 * kp + 16) * 256), k2 = *(const LAS bf16x8*)(Kim + oK2 + (32 * kp + 16) * 256), k3 = *(const LAS bf16x8*)(Kim + oK3 + (32 * kp + 16) * 256);
                  a1 = __builtin_amdgcn_mfma_f32_16x16x32_bf16(k0, qf[0], a1, 0, 0, 0); a1 = __builtin_amdgcn_mfma_f32_16x16x32_bf16(k1, qf[1], a1, 0, 0, 0);
                  a1 = __builtin_amdgcn_mfma_f32_16x16x32_bf16(k2, qf[2], a1, 0, 0, 0); a1 = __builtin_amdgcn_mfma_f32_16x16x32_bf16(k3, qf[3], a1, 0, 0, 0); }
                { const bool full0 = 2 * kp < w, diag0 = 2 * kp == w, full1 = 2 * kp + 1 < w, diag1 = 2 * kp + 1 == w;
#pragma unroll
                  for (int r = 0; r < 4; ++r) { const bool tri = fr >= 4 * fg + r;
                      a0[r] = (full0 || (diag0 && tri)) ? a0[r] : 0.f; a1[r] = (full1 || (diag1 && tri)) ? a1[r] : 0.f; } }
                const bf16x8 pf = __builtin_bit_cast(bf16x8, (u32x4){cvt_pk_bf16(a0[0], a0[1]), cvt_pk_bf16(a0[2], a0[3]), cvt_pk_bf16(a1[0], a1[1]), cvt_pk_bf16(a1[2], a1[3])});
                { const LAS unsigned char* v0 = Vim + oV0 + 32 * kp * 128; const LAS unsigned char* v1 = Vim + oV1 + 32 * kp * 128; const LAS unsigned char* v2 = Vim + oV2 + 32 * kp * 128; const LAS unsigned char* v3 = Vim + oV3 + 32 * kp * 128;
                  yi[0] = __builtin_amdgcn_mfma_f32_16x16x32_bf16(tr16x2(v0, v0 + 16 * 128), pf, yi[0], 0, 0, 0); yi[1] = __builtin_amdgcn_mfma_f32_16x16x32_bf16(tr16x2(v1, v1 + 16 * 128), pf, yi[1], 0, 0, 0);
                  yi[2] = __builtin_amdgcn_mfma_f32_16x16x32_bf16(tr16x2(v2, v2 + 16 * 128), pf, yi[2], 0, 0, 0); yi[3] = __builtin_amdgcn_mfma_f32_16x16x32_bf16(tr16x2(v3, v3 + 16 * 128), pf, yi[3], 0, 0, 0); }
            }
            RET_PIN(); if (n + 1 < 16) RET_ISSUE_Q(n + 1); RET_PIN();
#pragma unroll
            for (int ks = 0; ks < 4; ++ks)
#pragma unroll
                for (int u4 = 0; u4 < 4; ++u4) { const bf16x8 sf = *(const LAS bf16x8*)(Scur + oRow + 16 * u4 * RSK + 64 * ks); yi[u4] = __builtin_amdgcn_mfma_f32_16x16x32_bf16(sf, qf[ks], yi[u4], 0, 0, 0); }
            RET_PIN(); if (n + 1 < 16) RET_ISSUE_G(n + 1); RET_PIN();
#pragma unroll
            for (int ks = 0; ks < 4; ++ks) {
                const LAS unsigned char* ka = Kim + oKt + 32 * ks * 256;
                const bf16x8 kz = tr16x2(ka, ka + 16 * 256);
                const LAS unsigned char* v0 = Vim + oV0 + 32 * ks * 128; const LAS unsigned char* v1 = Vim + oV1 + 32 * ks * 128; const LAS unsigned char* v2 = Vim + oV2 + 32 * ks * 128; const LAS unsigned char* v3 = Vim + oV3 + 32 * ks * 128;
                st[0] = __builtin_amdgcn_mfma_f32_16x16x32_bf16(kz, tr16x2(v0, v0 + 16 * 128), st[0], 0, 0, 0); st[1] = __builtin_amdgcn_mfma_f32_16x16x32_bf16(kz, tr16x2(v1, v1 + 16 * 128), st[1], 0, 0, 0);
                st[2] = __builtin_amdgcn_mfma_f32_16x16x32_bf16(kz, tr16x2(v2, v2 + 16 * 128), st[2], 0, 0, 0); st[3] = __builtin_amdgcn_mfma_f32_16x16x32_bf16(kz, tr16x2(v3, v3 + 16 * 128), st[3], 0, 0, 0);
            }
#pragma unroll
            for (int u4 = 0; u4 < 4; ++u4) { u32x2 sw2; sw2.x = cvt_pk_bf16(st[u4][0], st[u4][1]); sw2.y = cvt_pk_bf16(st[u4][2], st[u4][3]);
                *(LAS u32x2*)(Snxt + oSw + 16 * u4 * RSK) = sw2; }
            float ss = 0.f; u32x2 yw[4];
#pragma unroll
            for (int u4 = 0; u4 < 4; ++u4) { const f32x4 y = yi[u4]; ss += (y[0] * y[0] + y[1] * y[1]) + (y[2] * y[2] + y[3] * y[3]);
                yw[u4].x = cvt_pk_bf16(silu_f(bflo(gr[u4].x)) * y[0], silu_f(bfhi(gr[u4].x)) * y[1]); yw[u4].y = cvt_pk_bf16(silu_f(bflo(gr[u4].y)) * y[2], silu_f(bfhi(gr[u4].y)) * y[3]); }
            ss += __shfl_xor(ss, 16); ss += __shfl_xor(ss, 32);
            asm volatile("s_waitcnt vmcnt(0) lgkmcnt(0)" ::: "memory");
#pragma unroll
            for (int ks = 0; ks < 4; ++ks) qf[ks] = __builtin_bit_cast(bf16x8, qr[ks]);
#pragma unroll
            for (int u4 = 0; u4 < 4; ++u4) gr[u4] = grn[u4];
            asm volatile("" ::: "memory");
#pragma unroll
            for (int u4 = 0; u4 < 4; ++u4) *(u32x2*)((dummy ? (bf16_t*)(p.ws + WS_SCR) + (size_t)(((b * 4 + h) * 4 + s) * SEQ) * 64 : vbase) + (size_t)(n * 128 + 16 * w + fr) * 64 + 16 * u4 + 4 * fg) = yw[u4];
            if (fg == 0) ssq[row * 16 + h * 4 + s] = ss;
        }
#undef RET_ISSUE
#undef RET_ISSUE_K
#undef RET_ISSUE_V
#undef RET_ISSUE_Q
#undef RET_ISSUE_G
#undef RET_PIN
    }
    }
    for (int rep3 = 0; rep3 < NREP(14); ++rep3) {
    bf16_t* MX = (bf16_t*)(p.ws + WS_H);
    const int gw = F.bx * NWAVES + F.wave, NGW = F.G * NWAVES;
    const int c = F.lane * 8, grp = F.lane >> 4, win = 2 << grp;
    for (int blk = gw; blk < T / 8; blk += NGW) {
        const int row0 = blk * 8; const int pos0 = row0 & (SEQ - 1);
        u32x4 R[23];
#pragma unroll
        for (int i = 0; i < 23; ++i) R[i] = *(const u32x4*)(P + ((long)(row0 - 15 + i) * 512) + c);
        if (pos0 < 15) {
#pragma unroll
            for (int i = 0; i < 15; ++i) if (pos0 - 15 + i < 0) R[i] = (u32x4){0u, 0u, 0u, 0u}; }
        float acc[8];
#pragma unroll
        for (int k = 0; k < 8; ++k) acc[k] = 0.f;
#pragma clang loop unroll(full)
        for (int j = 0; j < 16; ++j) { u32x4 uv = R[15 - j]; if (!(j < win)) uv = (u32x4){0u, 0u, 0u, 0u};
            acc[0] += bflo(uv.x); acc[1] += bfhi(uv.x); acc[2] += bflo(uv.y); acc[3] += bfhi(uv.y); acc[4] += bflo(uv.z); acc[5] += bfhi(uv.z); acc[6] += bflo(uv.w); acc[7] += bfhi(uv.w); }
#pragma clang loop unroll(full)
        for (int r = 0; r < 8; ++r) {
            const int pos = pos0 + r; const int cnt = (pos + 1) < win ? (pos + 1) : win;
            if (r > 0) { const u32x4 nv = R[15 + r]; const u32x4 o2 = R[13 + r], o4 = R[11 + r], o8 = R[7 + r], o16 = R[r - 1 < 0 ? 0 : r - 1];
                u32x4 ov = grp == 0 ? o2 : (grp == 1 ? o4 : (grp == 2 ? o8 : o16));
                acc[0] += bflo(nv.x) - bflo(ov.x); acc[1] += bfhi(nv.x) - bfhi(ov.x); acc[2] += bflo(nv.y) - bflo(ov.y); acc[3] += bfhi(nv.y) - bfhi(ov.y);
                acc[4] += bflo(nv.z) - bflo(ov.z); acc[5] += bfhi(nv.z) - bfhi(ov.z); acc[6] += bflo(nv.w) - bflo(ov.w); acc[7] += bfhi(nv.w) - bfhi(ov.w); }
            const u32x4 cu = R[15 + r]; const float inv = 1.0f / (float)cnt;
            u32x4 wv; wv.x = cvt_pk_bf16(acc[0] * inv - bflo(cu.x), acc[1] * inv - bfhi(cu.x)); wv.y = cvt_pk_bf16(acc[2] * inv - bflo(cu.y), acc[3] * inv - bfhi(cu.y));
            wv.z = cvt_pk_bf16(acc[4] * inv - bflo(cu.z), acc[5] * inv - bfhi(cu.z)); wv.w = cvt_pk_bf16(acc[6] * inv - bflo(cu.w), acc[7] * inv - bfhi(cu.w));
            *(u32x4*)(MX + (size_t)(row0 + r) * 512 + c) = wv;
        }
    }
    }
}

__device__ __forceinline__ void phase_norm2_route(const Params& p, const Ctx& F, int l, bool dummy = false) {
    LAS unsigned char* WF = F.lds;
    constexpr int OB = 98304;
    LAS int* se = (LAS int*)(F.lds + OB);
    LAS float* swl = (LAS float*)(F.lds + OB + 1024);
    LAS int* spos = (LAS int*)(F.lds + OB + 2048);
    LAS int* lcnt = (LAS int*)(F.lds + OB + 3072);
    LAS int* lbase = (LAS int*)(F.lds + OB + 3072 + 64);
    LAS float* lgt = (LAS float*)(F.lds + OB + 4096) + F.wave * 256;
    LAS float* avl = (LAS float*)(F.lds + OB + 12288);
    LAS float* cvl = (LAS float*)(F.lds + OB + 16384);
    {
        float wv[4][8];
#pragma unroll
        for (int k = 0; k < 4; ++k) { const int idx = F.tid + k * NTHR; const int e = idx & 15, g = (idx >> 4) & 3, ks = idx >> 6;
#pragma unroll
            for (int j = 0; j < 8; ++j) wv[k][j] = p.w_router[(size_t)(32 * ks + 8 * g + j) * NE + e]; }
#pragma unroll
        for (int k = 0; k < 4; ++k) { const int idx = F.tid + k * NTHR; const int fl = idx & 63, ks = idx >> 6;
            unsigned hi[4], mi[4], lo[4];
#pragma unroll
            for (int j = 0; j < 4; ++j) { const float a0 = wv[k][2 * j], a1 = wv[k][2 * j + 1];
                hi[j] = cvt_pk_bf16(a0, a1); const float r0 = a0 - bflo(hi[j]), r1 = a1 - bfhi(hi[j]);
                mi[j] = cvt_pk_bf16(r0, r1); lo[j] = cvt_pk_bf16(r0 - bflo(mi[j]), r1 - bfhi(mi[j])); }
            *(LAS u32x4*)(WF + ((ks * 3 + 0) * 64 + fl) * 16) = (u32x4){hi[0], hi[1], hi[2], hi[3]};
            *(LAS u32x4*)(WF + ((ks * 3 + 1) * 64 + fl) * 16) = (u32x4){mi[0], mi[1], mi[2], mi[3]};
            *(LAS u32x4*)(WF + ((ks * 3 + 2) * 64 + fl) * 16) = (u32x4){lo[0], lo[1], lo[2], lo[3]}; }
    }
    const float* mod = (const float*)(p.ws + WS_MOD);
    bf16_t* H = (bf16_t*)(p.ws + WS_H);
    unsigned* counts = (unsigned*)(p.ws + WS_CTL) + CW_CNT + l * 64 + (dummy ? 16 : 0);
    int* stok = (int*)(p.ws + (dummy ? WS_SCR : WS_STOK)); float* sw = (float*)(p.ws + (dummy ? WS_SCR + 4 * MiB : WS_SW));
    const int lane = F.lane;
    const bool b5 = (lane & 32) != 0, b4 = (lane & 16) != 0, b3 = (lane & 8) != 0, b2 = (lane & 4) != 0;
    for (int pass = F.bx; pass < T / 128; pass += F.G) {
        __syncthreads();
        if (F.tid < 16) lcnt[F.tid] = 0;
        const int row0 = pass * 128 + F.wave * 16, b = row0 / SEQ;
        const float* m1 = mod + (size_t)(l * NB + b) * 6144;
        { float ga[2], sa[2], ca[2];
#pragma unroll
          for (int k = 0; k < 2; ++k) { const int d = F.tid + k * NTHR; ga[k] = p.n2g[l * D + d]; sa[k] = m1[4096 + d]; ca[k] = m1[3072 + d]; }
#pragma unroll
          for (int k = 0; k < 2; ++k) { const int d = F.tid + k * NTHR; avl[d] = ga[k] * (sa[k] + 1.0f); cvl[d] = ca[k]; } }
        const bf16_t* XB = (const bf16_t*)(p.ws + WS_XB);
        const int tr = lane & 15, kg = lane >> 4;
        const bf16_t* xrow = XB + (size_t)(row0 + tr) * D + 8 * kg;
        __syncthreads();
        float ss = 0.f;
        { u32x4 xq[16];
#pragma unroll
          for (int hh = 0; hh < 2; ++hh) {
#pragma unroll
            for (int k = 0; k < 16; ++k) xq[k] = *(const u32x4*)(xrow + 32 * (hh * 16 + k));
#pragma unroll
            for (int k = 0; k < 16; ++k) { const u32x4 x = xq[k];
                ss += (bflo(x.x) * bflo(x.x) + bfhi(x.x) * bfhi(x.x)) + (bflo(x.y) * bflo(x.y) + bfhi(x.y) * bfhi(x.y)) + (bflo(x.z) * bflo(x.z) + bfhi(x.z) * bfhi(x.z)) + (bflo(x.w) * bflo(x.w) + bfhi(x.w) * bfhi(x.w)); }
            asm volatile("" ::: "memory"); } }
        ss += __shfl_xor(ss, 16); ss += __shfl_xor(ss, 32);
        const float rstd = rsqrtf(ss * (1.0f / D) + EPS);
        f32x4 lacc = (f32x4){0.f, 0.f, 0.f, 0.f};
        unsigned fo = (unsigned)(lane * 16), ao = (unsigned)(kg * 32); asm volatile("" : "+v"(fo), "+v"(ao));
        u32x4 xa[8], xb[8];
#define G_LOAD(dst, kb) do { _Pragma("unroll") for (int k = 0; k < 8; ++k) dst[k] = *(const u32x4*)(xrow + 32 * ((kb) * 8 + k)); } while (0)
#define G_PROC(src, kb) do { _Pragma("unroll") for (int k = 0; k < 8; ++k) { const int ks = (kb) * 8 + k; const u32x4 x = src[k]; \
            const f32x4 a0 = *(const LAS f32x4*)((const LAS unsigned char*)avl + ao + ks * 128), a1 = *(const LAS f32x4*)((const LAS unsigned char*)avl + ao + ks * 128 + 16); \
            const f32x4 c0 = *(const LAS f32x4*)((const LAS unsigned char*)cvl + ao + ks * 128), c1 = *(const LAS f32x4*)((const LAS unsigned char*)cvl + ao + ks * 128 + 16); \
            float h[8]; \
            h[0] = bflo(x.x) * rstd * a0[0] + c0[0]; h[1] = bfhi(x.x) * rstd * a0[1] + c0[1]; h[2] = bflo(x.y) * rstd * a0[2] + c0[2]; h[3] = bfhi(x.y) * rstd * a0[3] + c0[3]; \
            h[4] = bflo(x.z) * rstd * a1[0] + c1[0]; h[5] = bfhi(x.z) * rstd * a1[1] + c1[1]; h[6] = bflo(x.w) * rstd * a1[2] + c1[2]; h[7] = bfhi(x.w) * rstd * a1[3] + c1[3]; \
            unsigned hi[4], mi[4], lo[4]; \
            _Pragma("unroll") for (int j = 0; j < 4; ++j) { hi[j] = cvt_pk_bf16(h[2 * j], h[2 * j + 1]); const float r0 = h[2 * j] - bflo(hi[j]), r1 = h[2 * j + 1] - bfhi(hi[j]); \
                mi[j] = cvt_pk_bf16(r0, r1); lo[j] = cvt_pk_bf16(r0 - bflo(mi[j]), r1 - bfhi(mi[j])); } \
            const u32x4 hi4 = (u32x4){hi[0], hi[1], hi[2], hi[3]}; \
            *(u32x4*)(H + (size_t)(row0 + tr) * D + 32 * ks + 8 * kg) = hi4; \
            const bf16x8 ah = __builtin_bit_cast(bf16x8, hi4), am = __builtin_bit_cast(bf16x8, (u32x4){mi[0], mi[1], mi[2], mi[3]}), al = __builtin_bit_cast(bf16x8, (u32x4){lo[0], lo[1], lo[2], lo[3]}); \
            const bf16x8 wh = *(const LAS bf16x8*)(WF + fo + (ks * 3 + 0) * 1024), wm = *(const LAS bf16x8*)(WF + fo + (ks * 3 + 1) * 1024), wl = *(const LAS bf16x8*)(WF + fo + (ks * 3 + 2) * 1024); \
            lacc = __builtin_amdgcn_mfma_f32_16x16x32_bf16(al, wh, lacc, 0, 0, 0); lacc = __builtin_amdgcn_mfma_f32_16x16x32_bf16(ah, wl, lacc, 0, 0, 0); \
            lacc = __builtin_amdgcn_mfma_f32_16x16x32_bf16(am, wm, lacc, 0, 0, 0); lacc = __builtin_amdgcn_mfma_f32_16x16x32_bf16(am, wh, lacc, 0, 0, 0); \
            lacc = __builtin_amdgcn_mfma_f32_16x16x32_bf16(ah, wm, lacc, 0, 0, 0); lacc = __builtin_amdgcn_mfma_f32_16x16x32_bf16(ah, wh, lacc, 0, 0, 0); \
            if ((k & 1) == 1) asm volatile("" ::: "memory"); } } while (0)
        G_LOAD(xa, 0); G_LOAD(xb, 1);
        G_PROC(xa, 0); G_LOAD(xa, 2);
        G_PROC(xb, 1); G_LOAD(xb, 3);
        G_PROC(xa, 2); G_PROC(xb, 3);
#undef G_LOAD
#undef G_PROC
#pragma unroll
        for (int r = 0; r < 4; ++r) lgt[(4 * kg + r) * 16 + tr] = lacc[r];
        {
            const int t = lane & 15;
            float pr[NE]; float mx = -3.0e38f;
#pragma unroll
            for (int q = 0; q < 4; ++q) { const f32x4 x4 = *(const LAS f32x4*)(lgt + t * 16 + 4 * q); const f32x4 b4v = *(const f32x4*)(p.b_router + 4 * q);
                pr[4 * q] = x4[0] + b4v[0]; pr[4 * q + 1] = x4[1] + b4v[1]; pr[4 * q + 2] = x4[2] + b4v[2]; pr[4 * q + 3] = x4[3] + b4v[3]; }
#pragma unroll
            for (int e = 0; e < NE; ++e) mx = fmaxf(mx, pr[e]);
            float den = 0.f;
#pragma unroll
            for (int e = 0; e < NE; ++e) { pr[e] = __expf(pr[e] - mx); den += pr[e]; }
            const float rden = 1.0f / den;
#pragma unroll
            for (int e = 0; e < NE; ++e) pr[e] *= rden;
            float best = -1.0f; int sg = 0; float c0 = 0.f, c1 = 0.f, c2 = 0.f, c3 = 0.f;
#pragma unroll
            for (int g = 0; g < 4; ++g) { const float a0 = pr[4 * g], a1 = pr[4 * g + 1], a2 = pr[4 * g + 2], a3 = pr[4 * g + 3];
                const float hi01 = fmaxf(a0, a1), lo01 = fminf(a0, a1), hi23 = fmaxf(a2, a3), lo23 = fminf(a2, a3);
                const float m1v = fmaxf(hi01, hi23); const float m2v = fmaxf(fminf(hi01, hi23), fmaxf(lo01, lo23));
                const float gs = m1v + m2v;
                if (gs > best) { best = gs; sg = g; c0 = a0; c1 = a1; c2 = a2; c3 = a3; } }
            int i0 = 0; float p0 = c0;
            if (c1 > p0) { p0 = c1; i0 = 1; } if (c2 > p0) { p0 = c2; i0 = 2; } if (c3 > p0) { p0 = c3; i0 = 3; }
            int i1 = -1; float p1 = -1.0f;
            if (i0 != 0 && c0 > p1) { p1 = c0; i1 = 0; } if (i0 != 1 && c1 > p1) { p1 = c1; i1 = 1; } if (i0 != 2 && c2 > p1) { p1 = c2; i1 = 2; } if (i0 != 3 && c3 > p1) { p1 = c3; i1 = 3; }
            const float wsum = p0 + p1;
            if (lane < 16) { const int sl = (F.wave * 16 + t) * 2; se[sl] = sg * 4 + i0; se[sl + 1] = sg * 4 + i1; swl[sl] = p0 / wsum; swl[sl + 1] = p1 / wsum; }
        }
        __syncthreads();
        if (F.tid < 256) spos[F.tid] = atomicAdd((int*)&lcnt[se[F.tid]], 1);
        __syncthreads();
        if (F.tid < 16) lbase[F.tid] = (int)__hip_atomic_fetch_add(counts + F.tid, (unsigned)lcnt[F.tid], __ATOMIC_RELAXED, __HIP_MEMORY_SCOPE_AGENT);
        __syncthreads();
        if (F.tid < 256) { const int e = se[F.tid]; const int pos = lbase[e] + spos[F.tid]; const int tok = pass * 128 + (F.tid >> 1);
            stok[(size_t)e * CAP + pos] = tok * 2 + (F.tid & 1); sw[(size_t)e * CAP + pos] = swl[F.tid]; }
    }
    __syncthreads();
}

__device__ __forceinline__ void phase_final(const Params& p, const Ctx& F) {
    const float* mod = (const float*)(p.ws + WS_MOD);
    const bf16_t* ybuf = (const bf16_t*)(p.ws + WS_YBUF);
    const int gw = F.bx * NWAVES + F.wave, NGW = F.G * NWAVES;
    for (int blk = gw; blk < T / 16; blk += NGW) {
        const int row0 = blk * 16, b = row0 / SEQ;
        f32x4 gv[4], g2v[4];
#pragma unroll
        for (int i = 0; i < 4; ++i) { const int d = i * 256 + F.lane * 4; gv[i] = *(const f32x4*)(p.final_g + d); g2v[i] = *(const f32x4*)(mod + (size_t)((DEPTH - 1) * NB + b) * 6144 + 5120 + d); }
        const bf16_t* XB = (const bf16_t*)(p.ws + WS_XB);
        u32x2 nxb[4], ny0[4], ny1[4];
#pragma unroll
        for (int i = 0; i < 4; ++i) { const int d = i * 256 + F.lane * 4; const size_t row = (size_t)row0;
            nxb[i] = *(const u32x2*)(XB + row * D + d); ny0[i] = *(const u32x2*)(ybuf + (2 * row) * D + d); ny1[i] = *(const u32x2*)(ybuf + (2 * row + 1) * D + d); }
        for (int r = 0; r < 16; ++r) {
            const size_t row = (size_t)(row0 + r);
            f32x4 v[4]; u32x2 y0[4], y1[4]; float ss = 0.f;
#pragma unroll
            for (int i = 0; i < 4; ++i) { v[i] = (f32x4){bflo(nxb[i].x), bfhi(nxb[i].x), bflo(nxb[i].y), bfhi(nxb[i].y)}; y0[i] = ny0[i]; y1[i] = ny1[i]; }
            if (r + 1 < 16) {
#pragma unroll
                for (int i = 0; i < 4; ++i) { const int d = i * 256 + F.lane * 4; const size_t rn = row + 1;
                    nxb[i] = *(const u32x2*)(XB + rn * D + d); ny0[i] = *(const u32x2*)(ybuf + (2 * rn) * D + d); ny1[i] = *(const u32x2*)(ybuf + (2 * rn + 1) * D + d); } }
#pragma unroll
            for (int i = 0; i < 4; ++i) {
                f32x4 ys; ys[0] = bflo(y0[i].x) + bflo(y1[i].x); ys[1] = bfhi(y0[i].x) + bfhi(y1[i].x); ys[2] = bflo(y0[i].y) + bflo(y1[i].y); ys[3] = bfhi(y0[i].y) + bfhi(y1[i].y);
                v[i] = v[i] + g2v[i] * ys;
                ss += (v[i][0] * v[i][0] + v[i][1] * v[i][1]) + (v[i][2] * v[i][2] + v[i][3] * v[i][3]); }
            const float rstd = rsqrtf(wave_sum(ss) * (1.0f / D) + EPS);
#pragma unroll
            for (int i = 0; i < 4; ++i) { const int d = i * 256 + F.lane * 4; *(f32x4*)(p.out + row * D + d) = v[i] * rstd * gv[i]; }
        }
    }
}

constexpr int PH_PER_LAYER = 9, PH_TOTAL = 2 + DEPTH * PH_PER_LAYER;

__device__ __forceinline__ Params fresh_params() {
    Params r{};
#if defined(__HIP_DEVICE_COMPILE__)
    typedef const Params __attribute__((address_space(4))) KParams;
    KParams* q = (KParams*)__builtin_amdgcn_kernarg_segment_ptr(); asm volatile("" : "+s"(q));
    r.x = q->x; r.c = q->c; r.w_ada = q->w_ada; r.b_ada = q->b_ada; r.n1g = q->n1g; r.n2g = q->n2g; r.w_in = q->w_in; r.w_ret_o = q->w_ret_o; r.pool_w = q->pool_w; r.pool_scale = q->pool_scale;
    r.w_pool_o = q->w_pool_o; r.w_out = q->w_out; r.w_router = q->w_router; r.b_router = q->b_router; r.w_eg = q->w_eg; r.w_eu = q->w_eu; r.w_ed = q->w_ed; r.final_g = q->final_g;
    r.out = q->out; r.ws = q->ws; r.ph_lo = q->ph_lo; r.ph_hi = q->ph_hi;
#endif
    return r;
}
__global__ void __launch_bounds__(NTHR, 2) fwd_kernel(Params p0) {
    extern __shared__ __attribute__((aligned(16))) unsigned char lds_raw[];
    LAS unsigned char* const lds = (LAS unsigned char*)lds_raw;
    volatile LAS unsigned* bst = (volatile LAS unsigned*)(lds + LDS_BARW);
    if (threadIdx.x == 0) { bst[0] = 0u; bst[1] = 0u; bst[2] = 0u; bst[3] = 0u; }
    __syncthreads();
    XcdBarrier bar = xcd_barrier_post((unsigned*)(p0.ws + WS_CTL), bst);
    const int lo = p0.ph_lo, hi = p0.ph_hi;
#ifndef PHMASK
#define PHMASK 0xFFF
#endif
#define PSEL(j) ((PHMASK >> (j)) & 1)
#define IN(k) (lo <= (k) && (k) < hi)
#define SEAM(k) do { if (IN(k) && IN((k) + 1)) xcd_barrier(bar); } while (0)
#define PHASE_CTX() const Params p = fresh_params(); const Ctx F = make_ctx(lds); unsigned char* ws = p.ws; bf16_t* H = (bf16_t*)(ws + WS_H); \
    const int vcu = (F.G % 8 == 0) ? (F.bx % 8) * (F.G / 8) + F.bx / 8 : F.bx; (void)H; (void)vcu; (void)ws

    if (PSEL(10) && IN(0)) { PHASE_CTX(); phase_prologue(p, F); }
    SEAM(0);
    for (int l = 0; l < DEPTH; ++l) {
        const int pb = 1 + l * PH_PER_LAYER;
        if (PSEL(0) && IN(pb + 0)) { PHASE_CTX(); phase_norm1(p, F, l, NREP(12)); }
        SEAM(pb + 0);
        if (PSEL(1) && IN(pb + 1)) for (int rep = 0; rep < NREP(1); ++rep) { PHASE_CTX(); pg8::DenseOrder S; S.init(T, INW, F.G, F.bx, H, D, (const bf16_t*)(ws + WT_IN), D); S.wgm = 4;
            pg8::EpiProj E{ws, (const float*)(ws + WS_ROPE), (const float*)(ws + WS_ROPE) + SEQ * 64, (const float*)(ws + WS_DEC)};
            pg8::gemm_phase<pg8::EpiProj, pg8::DenseOrder>(F.lds, S, E, D, D, D); }
        SEAM(pb + 1);
        #ifdef USE_RET2
        if (PSEL(2) && IN(pb + 2)) { PHASE_CTX(); phase_ret2(p, F, vcu); }
#else
        if (PSEL(2) && IN(pb + 2)) { PHASE_CTX(); phase_ret3(p, F, vcu); }
#endif
        SEAM(pb + 2);
#ifdef USE_SUBUNITS
        if (PSEL(3) && IN(pb + 3)) for (int rep = 0; rep < NREP(3); ++rep) { PHASE_CTX(); pg8::HeadOrder S; S.d.init(T, D, F.G, F.bx, (const bf16_t*)(ws + WS_VB), 64, (const bf16_t*)(ws + WT_RO), D);
            pg8::EpiRet E{(const float*)(ws + WS_SSQ), ws + WS_GATE, (bf16_t*)(ws + WS_M1)};
            { pg8::DUnit tu; for (int i = 0; i < pg8::RTAB_MAXU && S.d.next(i, tu); ++i) E.fill_table(tu, i, F.tid, F.lds); __syncthreads(); }
            pg8::gemm_phase<pg8::EpiRet, pg8::HeadOrder>(F.lds, S, E, 256, 64, D, (size_t)SEQ * 64 * 2); }
#else
        if (PSEL(3) && IN(pb + 3)) for (int rep = 0; rep < NREP(3); ++rep) { PHASE_CTX(); pg8::RetOrder S; S.d.init(T, D, F.G, F.bx, (const bf16_t*)(ws + WS_VB), 64, (const bf16_t*)(ws + WT_RO), D); S.d.wgm = 4;
            pg8::EpiRetK E{(const float*)(ws + WS_SSQ), ws + WS_GATE, (bf16_t*)(ws + WS_M1)};
            { pg8::DUnit tu; for (int i = 0; i < pg8::RTAB_MAXU && S.next(i, tu); ++i) E.fill_table(tu, i, F.tid, F.lds); __syncthreads(); }
            pg8::gemm_phase<pg8::EpiRetK, pg8::RetOrder>(F.lds, S, E, D, 64, D, (size_t)SEQ * 64 * 2); }
#endif
        { asm volatile("s_waitcnt vmcnt(0)" ::: "memory"); __syncthreads(); }
        if (PSEL(4) && IN(pb + 4)) for (int rep = 0; rep < NREP(4); ++rep) { PHASE_CTX(); pg8::DenseOrder S; S.init(T, D, F.G, F.bx, H, 512, (const bf16_t*)(ws + WT_PE), 512); S.wgm = 4;
            pg8::EpiGate<true> E{ws + WS_GATE, 4, (const bf16_t*)(ws + WS_M1), D, (bf16_t*)(ws + WS_MRG), D};
            pg8::gemm_phase<pg8::EpiGate<true>, pg8::DenseOrder>(F.lds, S, E, 512, 512, 512); }
        SEAM(pb + 4);
        if (PSEL(5) && IN(pb + 5)) for (int rep = 0; rep < NREP(5); ++rep) { PHASE_CTX(); pg8::DenseOrder S; S.init(T, D, F.G, F.bx, (const bf16_t*)(ws + WS_MRG), D, (const bf16_t*)(ws + WT_OUT), D);
            if (l == 0) { pg8::EpiResid<true> E{p.x, nullptr, (bf16_t*)(ws + (rep + 1 < NREP(5) ? WS_SCR : WS_XB)), (const float*)(ws + WS_MOD) + 2048};
                pg8::gemm_phase<pg8::EpiResid<true>, pg8::DenseOrder>(F.lds, S, E, D, D, D); }
            else { pg8::EpiResid<false> E{nullptr, (const bf16_t*)(ws + WS_XB), (bf16_t*)(ws + (rep + 1 < NREP(5) ? WS_SCR : WS_XB)), (const float*)(ws + WS_MOD) + (size_t)l * NB * 6144 + 2048};
                pg8::gemm_phase<pg8::EpiResid<false>, pg8::DenseOrder>(F.lds, S, E, D, D, D); } }
        SEAM(pb + 5);
        if (PSEL(6) && IN(pb + 6)) for (int rep = 0; rep < NREP(6); ++rep) { PHASE_CTX(); phase_norm2_route(p, F, l, rep + 1 < NREP(6)); }
        SEAM(pb + 6);
        if (PSEL(7) && IN(pb + 7)) for (int rep = 0; rep < NREP(7); ++rep) {
            PHASE_CTX();
            LAS int* lc = (LAS int*)(F.lds + LDS_CNT);
            if (F.tid < 16) lc[F.tid] = (int)__hip_atomic_load((unsigned*)(ws + WS_CTL) + CW_CNT + l * 64 + F.tid, __ATOMIC_RELAXED, __HIP_MEMORY_SCOPE_AGENT);
            __syncthreads();
            pg8::MoeOrder<true> S; S.cnts = lc; S.G = F.G; S.c = vcu; S.A = (const char*)H; S.Bt = (const char*)(ws + WT_GU); S.atile = 0; S.bexp = (size_t)1024 * D * 2; S.btile = (size_t)256 * D * 2;
            S.stok = (const int*)(ws + WS_STOK); S.lda = D;
            { const MoeSplit ms = moe_split(lc, F.G); S.limit = ms.ufull; }
            pg8::EpiGateUp E{(bf16_t*)(ws + WS_ACT)};
            pg8::gemm_phase<pg8::EpiGateUp, pg8::MoeOrder<true>>(F.lds, S, E, D, D, D);
        }
        SEAM(pb + 7);
        if (PSEL(8) && IN(pb + 8)) for (int rep = 0; rep < NREP(8); ++rep) {
            PHASE_CTX();
            LAS int* lc = (LAS int*)(F.lds + LDS_CNT);
            if (F.tid < 16) lc[F.tid] = (int)__hip_atomic_load((unsigned*)(ws + WS_CTL) + CW_CNT + l * 64 + F.tid, __ATOMIC_RELAXED, __HIP_MEMORY_SCOPE_AGENT);
            __syncthreads();
            const MoeSplit ms = moe_split(lc, F.G);
            unsigned* flag = (unsigned*)(ws + WS_CTL) + CW_FLAG + l;
            if (vcu < ms.R) {
                pg8::MoeOrder<true> S2; S2.cnts = lc; S2.G = F.G; S2.c = vcu; S2.base = ms.ufull; S2.limit = ms.ufull + vcu + 1; S2.A = (const char*)H; S2.Bt = (const char*)(ws + WT_GU); S2.atile = 0; S2.bexp = (size_t)1024 * D * 2; S2.btile = (size_t)256 * D * 2;
                S2.stok = (const int*)(ws + WS_STOK); S2.lda = D;
                pg8::EpiGateUp E2{(bf16_t*)(ws + WS_ACT)};
                pg8::gemm_phase<pg8::EpiGateUp, pg8::MoeOrder<true>>(F.lds, S2, E2, D, D, D);
                if (F.tid == 0) { __builtin_amdgcn_fence(__ATOMIC_RELEASE, "agent"); asm volatile("s_waitcnt vmcnt(0)" ::: "memory"); (void)xb_add(flag, 1u); }
                __syncthreads();
            }
            pg8::MoeOrder<false> S; S.cnts = lc; S.G = F.G; S.c = vcu; S.dep_from = ms.R > 0 ? ms.ufull : 0x7fffffff; S.dep_flag = flag; S.dep_need = (unsigned)ms.R;
            if (ms.R > 0) { S.nfull = ms.ufull / F.G - 1; S.rank = vcu < ms.R ? -1 : vcu - ms.R; S.nrest = F.G - ms.R; }
            S.A = (const char*)(ws + WS_ACT); S.Bt = (const char*)(ws + WT_DN); S.atile = (size_t)256 * DE * 2; S.bexp = (size_t)D * DE * 2; S.btile = (size_t)256 * DE * 2;
            S.stok = (const int*)(ws + WS_STOK); S.lda = DE;
            pg8::EpiDown E{(bf16_t*)(ws + WS_YBUF), (const int*)(ws + WS_STOK), (const float*)(ws + WS_SW)};
            {
                unsigned tm[pg8::RTAB_MAXU], tw[pg8::RTAB_MAXU]; bool tv[pg8::RTAB_MAXU];
#pragma unroll
                for (int i = 0; i < pg8::RTAB_MAXU; ++i) { pg8::MUnit tu; tv[i] = S.next(i, tu); tm[i] = 0xffffffffu; tw[i] = 0u;
                    if (tv[i] && F.tid < 256) { const int pos = tu.pos0 + F.tid; if (pos < tu.cnt) { const size_t si = (size_t)tu.e * CAP + pos; tm[i] = (unsigned)E.stok[si]; tw[i] = __builtin_bit_cast(unsigned, E.sw[si]); } } }
#pragma unroll
                for (int i = 0; i < pg8::RTAB_MAXU; ++i) if (tv[i] && F.tid < 256) *(LAS u32x2*)(F.lds + pg8::LDS_RTAB + i * 4096 + F.tid * 8) = (u32x2){tm[i], tw[i]};
                __syncthreads();
            }
            pg8::gemm_phase<pg8::EpiDown, pg8::MoeOrder<false>>(F.lds, S, E, DE, 64, DE, (size_t)pg8::BM * 64 * 2);
        }
        SEAM(pb + 8);
    }
    if (PSEL(11) && IN(PH_TOTAL - 1)) { PHASE_CTX(); phase_final(p, F); }
#undef IN
#undef SEAM
}

extern "C" void kernel_launch(void* const* d_in, const int* in_sizes, int n_in, void* d_out, int out_size, void* d_ws, size_t ws_size, hipStream_t stream) {
    static int grid = 0;
    if (grid == 0) {
        if (n_in != 18 || in_sizes[0] != T * D || out_size != T * D || ws_size < WS_END) { fprintf(stderr, "kernel_launch: unexpected shapes / workspace (n_in %d, ws %zu)\n", n_in, ws_size); grid = -1; return; }
        int dev = 0, cus = 0, per_cu = 0;
        if (hipGetDevice(&dev) != hipSuccess || hipDeviceGetAttribute(&cus, hipDeviceAttributeMultiprocessorCount, dev) != hipSuccess) { grid = -1; return; }
        if (hipFuncSetAttribute((const void*)fwd_kernel, hipFuncAttributeMaxDynamicSharedMemorySize, LDS_BYTES) != hipSuccess) { fprintf(stderr, "kernel_launch: hipFuncSetAttribute failed\n"); grid = -1; return; }
        if (hipOccupancyMaxActiveBlocksPerMultiprocessor(&per_cu, (const void*)fwd_kernel, NTHR, LDS_BYTES) != hipSuccess || per_cu < 1) { fprintf(stderr, "kernel_launch: occupancy query says %d\n", per_cu); }
        (void)hipGetLastError();
        grid = cus;
    }
    if (grid < 0) return;
    if (hipMemsetAsync((char*)d_ws + WS_CTL, 0, CTL_ZERO_BYTES, stream) != hipSuccess) return;
    Params p{};
    p.x = (const float*)d_in[0]; p.c = (const float*)d_in[1]; p.w_ada = (const float*)d_in[2]; p.b_ada = (const float*)d_in[3]; p.n1g = (const float*)d_in[4]; p.n2g = (const float*)d_in[5];
    p.w_in = (const float*)d_in[6]; p.w_ret_o = (const float*)d_in[7]; p.pool_w = (const float*)d_in[8]; p.pool_scale = (const float*)d_in[9]; p.w_pool_o = (const float*)d_in[10]; p.w_out = (const float*)d_in[11];
    p.w_router = (const float*)d_in[12]; p.b_router = (const float*)d_in[13]; p.w_eg = (const float*)d_in[14]; p.w_eu = (const float*)d_in[15]; p.w_ed = (const float*)d_in[16]; p.final_g = (const float*)d_in[17];
    p.out = (float*)d_out; p.ws = (unsigned char*)d_ws; p.ph_lo = 0; p.ph_hi = PH_TOTAL;
    hipLaunchKernelGGL(fwd_kernel, dim3(grid), dim3(NTHR), LDS_BYTES, stream, p);
}
```
